# Optimizing an MI355X kernel written in HIP

```python
import math
import jax, jax.numpy as jnp
from jax import lax
import numpy as np

D_MODEL = 1024
BATCH = 8
SEQ = 4096
DEPTH = 4

GRID_W = 64
CTX_LEN = 256
SSM_WIDTH = D_MODEL // 2
SSM_GROUP = 16
SSM_GROUPS = SSM_WIDTH // SSM_GROUP
SSM_STATE = 64
ATTN_WIDTH = D_MODEL - SSM_WIDTH
HEAD_DIM = 64
N_HEADS = ATTN_WIDTH // HEAD_DIM
NA_ROWS_MAX = 8
NA_COLS = 16
IN_WIDTH = SSM_WIDTH + 3 * ATTN_WIDTH
D_FF = 2816
N_EXPERTS = 8
TOP_K = 2
D_FF_EXPERT = 3584
N_DENSE = (DEPTH + 1) // 2
N_MOE = DEPTH // 2
NORM_EPS = 1e-6
A_RE_MAX = -1e-4
DT_MIN = 1e-3
DT_MAX = 1e-1

kernel_name = "hymba_s5_natten_moe_dit"


def rms_norm(x, g):
    x32 = x.astype(jnp.float32)
    y = x32 * lax.rsqrt(jnp.mean(x32 * x32, axis=-1, keepdims=True) + NORM_EPS)
    return (y * g.astype(jnp.float32)).astype(x.dtype)


def modulate(h, shift, scale):
    return h * (1 + scale) + shift


def swiglu(t, w1, w3, w2):
    return (jax.nn.silu(t @ w1) * (t @ w3)) @ w2


def moe_swiglu(t, router, w1, w3, w2):
    logits = (t @ router).astype(jnp.float32)
    top_val, top_idx = lax.top_k(logits, TOP_K)
    top_w = jax.nn.softmax(top_val, axis=-1)
    gates = jnp.sum(jax.nn.one_hot(top_idx, N_EXPERTS, dtype=jnp.float32) * top_w[..., None], axis=1).astype(t.dtype)
    out = jnp.zeros_like(t)
    for e in range(N_EXPERTS):
        out = out + gates[:, e:e + 1] * swiglu(t, w1[e], w3[e], w2[e])
    return out


def ssm_discretize(a_re, a_im, log_step, b_re, b_im):
    f32 = jnp.float32
    a_re = jnp.minimum(a_re.astype(f32), A_RE_MAX)
    a_im = a_im.astype(f32)
    dt = jnp.exp(log_step.astype(f32))[:, None]
    mag = jnp.exp(a_re * dt)
    lam_re = mag * jnp.cos(a_im * dt)
    lam_im = mag * jnp.sin(a_im * dt)
    den = a_re * a_re + a_im * a_im
    z_re = ((lam_re - 1) * a_re + lam_im * a_im) / den
    z_im = (lam_im * a_re - (lam_re - 1) * a_im) / den
    b_re = b_re.astype(f32)
    b_im = b_im.astype(f32)
    bb_re = z_re[..., None] * b_re - z_im[..., None] * b_im
    bb_im = z_re[..., None] * b_im + z_im[..., None] * b_re
    return lam_re, lam_im, bb_re, bb_im


def complex_scan(lam_re, lam_im, b_re, b_im, reverse):
    n = b_re.shape[1]
    a_re = jnp.broadcast_to(lam_re, (1, n) + lam_re.shape)
    a_im = jnp.broadcast_to(lam_im, (1, n) + lam_im.shape)

    def combine(e1, e2):
        a1r, a1i, b1r, b1i = e1
        a2r, a2i, b2r, b2i = e2
        return (a2r * a1r - a2i * a1i, a2r * a1i + a2i * a1r,
                a2r * b1r - a2i * b1i + b2r, a2r * b1i + a2i * b1r + b2i)

    return lax.associative_scan(combine, (a_re, a_im, b_re, b_im), reverse=reverse, axis=1)


def ssm_readout(h_re, h_im, c_re, c_im):
    return jnp.einsum('blgp,ghp->blgh', h_re, c_re) - jnp.einsum('blgp,ghp->blgh', h_im, c_im)


def ssm_mixer(u, u_c, a_re, a_im, log_step, b_re, b_im, c_re, c_im, d_skip, w_glu, b_glu, with_ctx_out):
    f32 = jnp.float32
    bsz, seq, _ = u.shape
    n_ctx = u_c.shape[1]
    ug = u.astype(f32).reshape(bsz, seq, SSM_GROUPS, SSM_GROUP)
    ucg = u_c.astype(f32).reshape(bsz, n_ctx, SSM_GROUPS, SSM_GROUP)
    d = d_skip.astype(f32).reshape(SSM_GROUPS, SSM_GROUP)
    y = ug * d
    yc = ucg * d if with_ctx_out else None
    for direction in range(2):
        reverse = direction == 1
        lam_re, lam_im, bb_re, bb_im = ssm_discretize(a_re[direction], a_im[direction], log_step[direction],
                                                      b_re[direction], b_im[direction])
        cre = c_re[direction].astype(f32)
        cim = c_im[direction].astype(f32)
        dc_re = jnp.einsum('blgh,gph->blgp', ucg, bb_re)
        dc_im = jnp.einsum('blgh,gph->blgp', ucg, bb_im)
        _, _, hc_re, hc_im = complex_scan(lam_re, lam_im, dc_re, dc_im, reverse)
        end = 0 if reverse else n_ctx - 1
        h0_re = hc_re[:, end][:, None]
        h0_im = hc_im[:, end][:, None]
        dx_re = jnp.einsum('blgh,gph->blgp', ug, bb_re)
        dx_im = jnp.einsum('blgh,gph->blgp', ug, bb_im)
        p_re, p_im, s_re, s_im = complex_scan(lam_re, lam_im, dx_re, dx_im, reverse)
        h_re = p_re * h0_re - p_im * h0_im + s_re
        h_im = p_re * h0_im + p_im * h0_re + s_im
        y = y + ssm_readout(h_re, h_im, cre, cim)
        if with_ctx_out:
            yc = yc + ssm_readout(hc_re, hc_im, cre, cim)

    def glu(yy, n):
        g = jax.nn.gelu(yy.reshape(bsz, n, SSM_WIDTH)).astype(u.dtype)
        return g * jax.nn.sigmoid(g @ w_glu + b_glu)

    out = glu(y, seq)
    out_c = glu(yc, n_ctx) if with_ctx_out else None
    return out, out_c


def context_attention(qc, kc, vc):
    s = jnp.einsum('bqhd,bkhd->bhqk', qc, kc).astype(jnp.float32) * (HEAD_DIM ** -0.5)
    p = jax.nn.softmax(s, axis=-1).astype(vc.dtype)
    return jnp.einsum('bhqk,bkhd->bqhd', p, vc)


def neighbourhood_attention(q, k, v, kc, vc, rpb):
    bsz, seq = q.shape[0], q.shape[1]
    rows = seq // GRID_W
    win_r = min(NA_ROWS_MAX, rows)
    n_lat = win_r * NA_COLS
    grid = (bsz, rows, GRID_W, N_HEADS, HEAD_DIM)
    qg, kg, vg = q.reshape(grid), k.reshape(grid), v.reshape(grid)
    col = jnp.arange(GRID_W)
    col_start = jnp.clip(col - NA_COLS // 2, 0, GRID_W - NA_COLS)
    col_idx = col_start[:, None] + jnp.arange(NA_COLS)[None, :]
    col_rel = col_idx - col[:, None] + NA_COLS - 1
    scale = HEAD_DIM ** -0.5

    def row_block(r):
        r_start = jnp.clip(r - win_r // 2, 0, rows - win_r)
        q_r = lax.dynamic_index_in_dim(qg, r, axis=1, keepdims=False)
        k_band = lax.dynamic_slice_in_dim(kg, r_start, win_r, axis=1)
        v_band = lax.dynamic_slice_in_dim(vg, r_start, win_r, axis=1)
        k_win = k_band[:, :, col_idx]
        v_win = v_band[:, :, col_idx]
        row_rel = r_start + jnp.arange(win_r) - r + NA_ROWS_MAX - 1
        bias = jnp.transpose(rpb[:, row_rel][:, :, col_rel], (0, 2, 1, 3)).astype(jnp.float32)
        s_lat = jnp.einsum('bchd,brcjhd->bhcrj', q_r, k_win).astype(jnp.float32) * scale + bias
        s_ctx = jnp.einsum('bchd,bkhd->bhck', q_r, kc).astype(jnp.float32) * scale
        s = jnp.concatenate([s_lat.reshape(bsz, N_HEADS, GRID_W, n_lat), s_ctx], axis=-1)
        p = jax.nn.softmax(s, axis=-1).astype(v.dtype)
        p_lat = p[..., :n_lat].reshape(bsz, N_HEADS, GRID_W, win_r, NA_COLS)
        p_ctx = p[..., n_lat:]
        return (jnp.einsum('bhcrj,brcjhd->bchd', p_lat, v_win)
                + jnp.einsum('bhck,bkhd->bchd', p_ctx, vc))

    out = lax.map(row_block, jnp.arange(rows))
    return jnp.transpose(out, (1, 0, 2, 3, 4)).reshape(bsz, seq, ATTN_WIDTH)


def setup_inputs(seed: int = 0) -> dict:
    key = jax.random.key(seed)
    ks = iter(jax.random.split(key, 32))
    f32 = jnp.float32

    def nrm(shape, s):
        return jax.random.normal(next(ks), shape, f32) * s

    D = D_MODEL
    G, P, H = SSM_GROUPS, SSM_STATE, SSM_GROUP
    n_idx = jnp.arange(P, dtype=f32)
    return {
        "x": nrm((BATCH, SEQ, D), 1.0),
        "c": nrm((BATCH, D), 1.0),
        "ctx": nrm((BATCH, CTX_LEN, D), 1.0),
        "c_ctx": nrm((D,), 1.0),
        "w_mod": nrm((DEPTH, D, 6 * D), 0.5 * D ** -0.5),
        "b_mod": nrm((DEPTH, 6 * D), 0.02),
        "g_mix": 1.0 + nrm((DEPTH, D), 0.02),
        "g_ffn": 1.0 + nrm((DEPTH, D), 0.02),
        "w_in": nrm((DEPTH, D, IN_WIDTH), D ** -0.5),
        "w_out": nrm((DEPTH, SSM_WIDTH + ATTN_WIDTH, D), (SSM_WIDTH + ATTN_WIDTH) ** -0.5),
        "ssm_a_re": -0.5 + nrm((DEPTH, 2, G, P), 0.01),
        "ssm_a_im": jnp.pi * n_idx + nrm((DEPTH, 2, G, P), 0.01),
        "ssm_log_step": jax.random.uniform(next(ks), (DEPTH, 2, G), f32, math.log(DT_MIN), math.log(DT_MAX)),
        "ssm_b_re": nrm((DEPTH, 2, G, P, H), (2 * H) ** -0.5),
        "ssm_b_im": nrm((DEPTH, 2, G, P, H), (2 * H) ** -0.5),
        "ssm_c_re": nrm((DEPTH, 2, G, H, P), P ** -0.5),
        "ssm_c_im": nrm((DEPTH, 2, G, H, P), P ** -0.5),
        "ssm_d": nrm((DEPTH, SSM_WIDTH), 1.0),
        "glu_w": nrm((DEPTH, SSM_WIDTH, SSM_WIDTH), SSM_WIDTH ** -0.5),
        "glu_b": nrm((DEPTH, SSM_WIDTH), 0.02),
        "na_rpb": nrm((DEPTH, N_HEADS, 2 * NA_ROWS_MAX - 1, 2 * NA_COLS - 1), 0.1),
        "ffn_w1": nrm((N_DENSE, D, D_FF), D ** -0.5),
        "ffn_w3": nrm((N_DENSE, D, D_FF), D ** -0.5),
        "ffn_w2": nrm((N_DENSE, D_FF, D), D_FF ** -0.5),
        "moe_router": nrm((N_MOE, D, N_EXPERTS), D ** -0.5),
        "moe_w1": nrm((N_MOE, N_EXPERTS, D, D_FF_EXPERT), D ** -0.5),
        "moe_w3": nrm((N_MOE, N_EXPERTS, D, D_FF_EXPERT), D ** -0.5),
        "moe_w2": nrm((N_MOE, N_EXPERTS, D_FF_EXPERT, D), D_FF_EXPERT ** -0.5),
        "g_final": 1.0 + nrm((D,), 0.02),
    }


def reference(x, c, ctx, c_ctx, w_mod, b_mod, g_mix, g_ffn, w_in, w_out, ssm_a_re, ssm_a_im, ssm_log_step,
              ssm_b_re, ssm_b_im, ssm_c_re, ssm_c_im, ssm_d, glu_w, glu_b, na_rpb, ffn_w1, ffn_w3, ffn_w2,
              moe_router, moe_w1, moe_w3, moe_w2, g_final):
    bsz, seq, d = x.shape
    n_ctx = ctx.shape[1]
    silu_c = jax.nn.silu(c)
    silu_cc = jax.nn.silu(c_ctx)
    split_cols = [SSM_WIDTH, SSM_WIDTH + ATTN_WIDTH, SSM_WIDTH + 2 * ATTN_WIDTH]

    def heads(t):
        return t.reshape(t.shape[0], t.shape[1], N_HEADS, HEAD_DIM)

    xc = ctx
    for l in range(DEPTH):
        last = l == DEPTH - 1
        sh1, sc1, gt1, sh2, sc2, gt2 = jnp.split((silu_c @ w_mod[l] + b_mod[l])[:, None, :], 6, axis=-1)
        sh1c, sc1c, gt1c, sh2c, sc2c, gt2c = jnp.split(silu_cc @ w_mod[l] + b_mod[l], 6, axis=-1)

        h = modulate(rms_norm(x, g_mix[l]), sh1, sc1)
        hc = modulate(rms_norm(xc, g_mix[l]), sh1c, sc1c)
        u, q, k, v = jnp.split(h @ w_in[l], split_cols, axis=-1)
        if last:
            uc = hc @ w_in[l][:, :SSM_WIDTH]
            kc, vc = jnp.split(hc @ w_in[l][:, SSM_WIDTH + ATTN_WIDTH:], 2, axis=-1)
            qc = None
        else:
            uc, qc, kc, vc = jnp.split(hc @ w_in[l], split_cols, axis=-1)

        y_ssm, yc_ssm = ssm_mixer(u, uc, ssm_a_re[l], ssm_a_im[l], ssm_log_step[l], ssm_b_re[l], ssm_b_im[l],
                                  ssm_c_re[l], ssm_c_im[l], ssm_d[l], glu_w[l], glu_b[l], not last)
        kc_h, vc_h = heads(kc), heads(vc)
        y_att = neighbourhood_attention(heads(q), heads(k), heads(v), kc_h, vc_h, na_rpb[l])
        x = x + gt1 * (jnp.concatenate([y_ssm, y_att], axis=-1) @ w_out[l])
        if not last:
            yc_att = context_attention(heads(qc), kc_h, vc_h).reshape(bsz, n_ctx, ATTN_WIDTH)
            xc = xc + gt1c * (jnp.concatenate([yc_ssm, yc_att], axis=-1) @ w_out[l])

        tokens = modulate(rms_norm(x, g_ffn[l]), sh2, sc2).reshape(bsz * seq, d)
        if not last:
            tokens_c = modulate(rms_norm(xc, g_ffn[l]), sh2c, sc2c).reshape(bsz * n_ctx, d)
            tokens = jnp.concatenate([tokens, tokens_c], axis=0)
        if l % 2 == 0:
            f = swiglu(tokens, ffn_w1[l // 2], ffn_w3[l // 2], ffn_w2[l // 2])
        else:
            f = moe_swiglu(tokens, moe_router[l // 2], moe_w1[l // 2], moe_w3[l // 2], moe_w2[l // 2])
        x = x + gt2 * f[:bsz * seq].reshape(bsz, seq, d)
        if not last:
            xc = xc + gt2c * f[bsz * seq:].reshape(bsz, n_ctx, d)

    return rms_norm(x, g_final)
```

```cpp
#include <hip/hip_runtime.h>
#include <cstdio>
#include <cstdint>

#define MK_DIAG_PREPB 0
#define MK_BLOCKED_ACT 0
#define MK_SSM_FUSED 1
#define MK_ACT_LD 2816
#define MK_WGM 4
#define MK_WGM_M1 4
#define MK_WGM_SSM 8
#define MK_WGM_INP 4
#define MK_WGM_GLU 4
#define MK_WGM_OUT 4
#define MK_WGM_F1 4
#define MK_WGM_F2 4
#define MK_WGM_M2 2
#define MK_SPLIT_M2 1
#define MK_CONV_SEAM 1
#define MK_ALIGN_EPI 1
#define MK_ATT_SPREAD 1
#define MK_WT_STORES 0
#define MK_SPLIT_OUT 4
#define MK_SPLIT_FFN2 4
#ifndef MK_ONE_LAUNCH
#define MK_ONE_LAUNCH 1
#endif

#define GAS __attribute__((address_space(1)))
#define LAS __attribute__((address_space(3)))
typedef unsigned short bf16;
typedef unsigned v4u __attribute__((ext_vector_type(4)));
typedef unsigned v2u __attribute__((ext_vector_type(2)));
typedef float f32x4 __attribute__((ext_vector_type(4)));
typedef float f32x2 __attribute__((ext_vector_type(2)));
typedef short bf16x8 __attribute__((ext_vector_type(8)));
typedef short bf16x4 __attribute__((ext_vector_type(4)));
typedef GAS unsigned gu32;

constexpr int D = 1024, NBATCH = 8, SEQ = 4096, DEPTH = 4, CTXL = 256;
constexpr int MLAT = NBATCH * SEQ, MCTX = NBATCH * CTXL, MTOT = MLAT + MCTX;
constexpr int SSMW = 512, NG = 32, NPS = 64, ATTW = 512, HD = 64, NH = 8, INW = 2048, DFF = 2816, NE = 8, DFE = 3584;
constexpr int NCRP = 1280, KY = 768;
constexpr float NORM_EPS = 1e-6f;
constexpr float QSCALE = 0.125f * 1.4426950408889634f;
constexpr float LOG2E = 1.4426950408889634f;
constexpr int MOE_MAXP = 280, MOE_HALFP = 140;
constexpr int ACT_LD = MK_ACT_LD;

constexpr size_t MiB = 1u << 20;
constexpr size_t WS_CTL = 0, CTL_ZERO_BYTES = 1 * MiB;
constexpr size_t WS_MOD = 1 * MiB;
constexpr size_t WS_ROUTE = 2 * MiB;
constexpr size_t WS_BTS = 4 * MiB;
constexpr size_t WS_BTY = 12 * MiB;
constexpr size_t WS_WIN = 36 * MiB;
constexpr size_t WS_WOUT = 40 * MiB;
constexpr size_t WS_WGLU = 42 * MiB;
constexpr size_t WS_W13 = 44 * MiB;
constexpr size_t WS_W2 = 156 * MiB;
constexpr size_t WS_DW13 = 720 * MiB, WS_DW2 = 731 * MiB;
constexpr size_t WS_WIN1 = 740 * MiB, WS_WOUT1 = 744 * MiB, WS_WGLU1 = 746 * MiB;
__device__ __forceinline__ size_t ws_win(int l) { return (l & 1) ? WS_WIN1 : (size_t)(36 * MiB); }
__device__ __forceinline__ size_t ws_wout(int l) { return (l & 1) ? WS_WOUT1 : (size_t)(40 * MiB); }
__device__ __forceinline__ size_t ws_wglu(int l) { return (l & 1) ? WS_WGLU1 : (size_t)(42 * MiB); }
__device__ __forceinline__ size_t ws_w13(int l) { return (l & 1) ? WS_W13 : WS_DW13; }
__device__ __forceinline__ size_t ws_w2(int l) { return (l & 1) ? WS_W2 : WS_DW2; }
constexpr size_t WS_X = 212 * MiB;
constexpr size_t WS_HB = 348 * MiB;
constexpr size_t WS_AY = 416 * MiB;
constexpr size_t WS_S = 476 * MiB;
constexpr size_t WS_Q = 516 * MiB, WS_K = 550 * MiB, WS_V = 584 * MiB;
static_assert(WS_V - WS_K == WS_K - WS_Q, "q/k/v spacing");
constexpr size_t WS_G = 618 * MiB;
constexpr size_t WS_YA = 652 * MiB;
constexpr size_t WS_ACT = 416 * MiB;
constexpr size_t WS_XS = 838 * MiB;
constexpr size_t WS_ACTS = 348 * MiB;
constexpr size_t WS_YS = WS_XS;
constexpr size_t WS_KTG = 978 * MiB;
constexpr size_t WS_SLAB = 980 * MiB;
constexpr size_t WS_END = 1012 * MiB;
constexpr int CW_TMO = 0;
constexpr int CW_BAR = 4096;
constexpr int CW_CNT = 8192;
constexpr int CW_CUR = 8256;
constexpr int CW_BCNT = 24576;
constexpr int CW_Q = 12288;

constexpr int RING_BYTES = 131072;
constexpr int LDSCTL_OFF = 144 * 1024, MISC_OFF = LDSCTL_OFF + 320;
constexpr int LDS_BYTES = 152 * 1024;

#define RLX_AGENT __ATOMIC_RELAXED, __HIP_MEMORY_SCOPE_AGENT
#define LDS_WAIT() asm volatile("s_waitcnt lgkmcnt(0)" ::: "memory")
#define VM_WAIT() asm volatile("s_waitcnt vmcnt(0)" ::: "memory")
__device__ __forceinline__ unsigned f2bf(float f) { unsigned u = __builtin_bit_cast(unsigned, f); return (u + 0x7fffu + ((u >> 16) & 1u)) >> 16; }
__device__ __forceinline__ unsigned pk2(float lo, float hi) { return f2bf(lo) | (f2bf(hi) << 16); }
__device__ __forceinline__ float bf2f(unsigned short b) { return __builtin_bit_cast(float, ((unsigned)b) << 16); }
__device__ __forceinline__ float bflo(unsigned w) { return __builtin_bit_cast(float, w << 16); }
__device__ __forceinline__ float bfhi(unsigned w) { return __builtin_bit_cast(float, w & 0xffff0000u); }
typedef __bf16 bf16x2_t __attribute__((ext_vector_type(2)));
__device__ __forceinline__ unsigned cvt_pk_bf16(float lo, float hi) { const f32x2 v = {lo, hi}; const bf16x2_t b = __builtin_convertvector(v, bf16x2_t); return __builtin_bit_cast(unsigned, b); }
__device__ __forceinline__ float fast_rcp(float x) { return __builtin_amdgcn_rcpf(x); }
__device__ __forceinline__ float sigmoidf_(float x) { return fast_rcp(1.0f + __builtin_amdgcn_exp2f(-x * LOG2E)); }
__device__ __forceinline__ float siluf_(float x) { return x * sigmoidf_(x); }
__device__ __forceinline__ float gelu_tanh(float x) {
    const float u = 0.7978845608028654f * (x + 0.044715f * x * x * x);
    return x * sigmoidf_(2.0f * u);
}
__device__ __forceinline__ float wave_sum(float v) {
#pragma unroll
    for (int o = 1; o < 64; o <<= 1) v += __shfl_xor(v, o);
    return v;
}

__device__ __forceinline__ int lt_s(int v) { asm volatile("" : "+s"(v)); return v; }
__device__ __forceinline__ int lt_tid() { int t = threadIdx.x; asm volatile("" : "+v"(t)); return t; }

namespace pg8 {
#define PG8_LAS __attribute__((address_space(3)))
typedef unsigned short bf16_t;
constexpr int BM = 256, BK = 64, HALF = 128, HTB = HALF * BK * 2, STAGE_BYTES = 8 * HTB, NXCD = 8, WGM = MK_WGM;
__host__ __device__ __forceinline__ int lds_byte(int r, int c) { const int st = (r >> 4) * 2 + (c >> 5), rr = r & 15, cc = c & 31, ob = rr * 64 + cc * 2; return st * 1024 + (ob ^ (((ob >> 9) & 1) << 5)); }
__host__ __device__ __forceinline__ void stage_rc(int b, int& R, int& C) { const int st = b / 1024, sb = b % 1024, swz = sb ^ (((sb >> 9) & 1) << 5); R = (st >> 1) * 16 + swz / 64; C = (st & 1) * 32 + (swz % 64) / 2; }
__host__ __device__ __forceinline__ int perm32(int rho) { const int n = rho >> 4, i = rho & 15; return 8 * (i >> 2) + 4 * n + (i & 3); }

struct Unit { int pm, pn; size_t aoff, boff; int nt, atomic; };
struct Gemm { const bf16_t* A; const bf16_t* Bt; int K, lda, ldb; int kstepA = BK * 2; };

struct TileOrder {
    int nM, nN, nwg, G, c; size_t sA, sB; int bdiv;
    int wgm = WGM; int skip5 = 0; int kpA = 256;
    int ntk = 0, nsplit = 1, xpm0 = 0, xnp = 0;
    __device__ void init(int nM_, int nN_, int G_, int c_, size_t sA_, size_t sB_, int bdiv_) { nM = nM_; nN = nN_; nwg = nM * nN; G = G_; c = c_; sA = sA_; sB = sB_; bdiv = bdiv_; }
    __device__ bool next(int i, Unit& u) const {
        const long L = (long)i * G + c;
        u.nt = 0; u.atomic = 0;
        if (L >= nwg) {
            if (xnp == 0) return false;
            const int Lp = (int)(L - nwg); if (Lp >= xnp * nN * nsplit) return false;
            const int uu = Lp / nsplit, part = Lp - uu * nsplit;
            u.pm = xpm0 + uu / nN; u.pn = uu % nN; u.atomic = 1 + part;
            const int pairs = ntk / 2, base = pairs / nsplit, rem = pairs % nsplit; const int np = base + (part < rem ? 1 : 0), p0 = part * base + (part < rem ? part : rem);
            u.nt = 2 * np; u.aoff = (size_t)u.pm * sA + (size_t)p0 * kpA; u.boff = (size_t)u.pn * sB + (size_t)p0 * 256;
            return true;
        }
        int wgid = (int)L; { const int q = nwg / NXCD, r = nwg % NXCD, xcd = wgid % NXCD, off = wgid / NXCD; wgid = (xcd < r ? xcd * (q + 1) : r * (q + 1) + (xcd - r) * q) + off; }
        const int nig = wgm * nN, gid = wgid / nig, fm = gid * wgm, gsz = (nM - fm) < wgm ? (nM - fm) : wgm;
        u.pm = fm + ((wgid % nig) % gsz); u.pn = (wgid % nig) / gsz;
        if (skip5) u.pm = (u.pm >> 2) * 5 + (u.pm & 3);
        u.aoff = (size_t)u.pm * sA; u.boff = (size_t)(bdiv > 0 ? (u.pm / bdiv) * nN + u.pn : u.pn) * sB;
        return true;
    }
};
struct MoeOrder {
    int nM, nN, nwg, G, c, p0; size_t sA, sB; int segp[9]; int a_local;
    int wgm = WGM;
    int xpm0 = 0, xnp = 0, ntk = 0;
    __device__ bool next(int i, Unit& u) const {
        const long L = (long)i * G + c;
        int pl;
        if (L >= nwg) {
            if (xnp == 0) return false;
            const int Lp = (int)(L - nwg); if (Lp >= xnp * nN * 2) return false;
            const int uu = Lp >> 1, part = Lp & 1;
            pl = xpm0 + uu / nN; u.pn = uu % nN; u.pm = p0 + pl; u.nt = ntk / 2; u.atomic = 1 + part;
            int e = 0;
#pragma unroll
            for (int j = 1; j < 8; ++j) e += (u.pm >= segp[j]) ? 1 : 0;
            const size_t ko = (size_t)part * (size_t)(ntk / 2) * 128;
            u.aoff = (size_t)(a_local ? pl : u.pm) * sA + ko; u.boff = (size_t)(e * nN + u.pn) * sB + ko; return true;
        }
        int wgid = (int)L; { const int q = nwg / NXCD, r = nwg % NXCD, xcd = wgid % NXCD, off = wgid / NXCD; wgid = (xcd < r ? xcd * (q + 1) : r * (q + 1) + (xcd - r) * q) + off; }
        const int nig = wgm * nN, gid = wgid / nig, fm = gid * wgm, gsz = (nM - fm) < wgm ? (nM - fm) : wgm;
        pl = fm + ((wgid % nig) % gsz); u.pn = (wgid % nig) / gsz; u.pm = p0 + pl;
        int e = 0;
#pragma unroll
        for (int j = 1; j < 8; ++j) e += (u.pm >= segp[j]) ? 1 : 0;
        u.aoff = (size_t)(a_local ? pl : u.pm) * sA; u.boff = (size_t)(e * nN + u.pn) * sB; u.nt = 0; u.atomic = 0; return true;
    }
};

template <class Epi, class Sched>
__device__ __forceinline__ void gemm_phase(PG8_LAS unsigned char* lds, const Gemm g, const Sched& S, const Epi& E) {
    const int tid = lt_tid(), wid = __builtin_amdgcn_readfirstlane(tid >> 6), lane = tid & 63, wr = wid >> 2, wc = wid & 3, fr = lane & 15, fq = lane >> 4;
    const int K = g.K, nt = K / BK;
    unsigned voffA[2], voffB[2];
#pragma unroll
    for (int i = 0; i < 2; ++i) { int R, C; stage_rc(tid * 16 + i * 8192, R, C); const int Rb = Epi::PERM ? ((R & ~31) + perm32(R & 31)) : R;
        voffA[i] = (unsigned)(R * g.lda + C) * 2u; voffB[i] = (unsigned)(Rb * g.ldb + C) * 2u; }
    const size_t kstep = (size_t)(BK * 2), kstepA = (size_t)g.kstepA;
    const size_t hstepA = (size_t)HALF * g.lda * 2, hstepB = (size_t)HALF * g.ldb * 2;
    const unsigned ldsw = (unsigned)wid * 1024u;
    const int aoff = lds_byte(wr * 64 + fr, fq * 8), boff = lds_byte(wc * 32 + fr, fq * 8);
#define PG8_SA(b, h) (((b) * 2 + (h)) * HTB)
#define PG8_SB(b, h) ((4 + (b) * 2 + (h)) * HTB)
#define PG8_STAGE(bufoff, gbase, voff) do { _Pragma("unroll") for (int _i = 0; _i < 2; ++_i) \
        __builtin_amdgcn_global_load_lds((const unsigned*)((const char*)(gbase) + (voff)[_i]), (PG8_LAS unsigned*)(lds + (bufoff) + ldsw + _i * 8192), 16, 0, 0); } while (0)
#define PG8_LDA(dst, b, h) do { _Pragma("unroll") for (int m = 0; m < 4; ++m) _Pragma("unroll") for (int k = 0; k < 2; ++k) dst[m][k] = *(const PG8_LAS bf16x8*)(lds + PG8_SA(b, h) + aoff + m * 2048 + k * 1024); } while (0)
#define PG8_LDB(dst, b, h) do { _Pragma("unroll") for (int n = 0; n < 2; ++n) _Pragma("unroll") for (int k = 0; k < 2; ++k) dst[n][k] = *(const PG8_LAS bf16x8*)(lds + PG8_SB(b, h) + boff + n * 2048 + k * 1024); } while (0)
#define PG8_MMA(ai, bj, At, Bt) do { __builtin_amdgcn_s_setprio(1); _Pragma("unroll") for (int m = 0; m < 4; ++m) _Pragma("unroll") for (int n = 0; n < 2; ++n) _Pragma("unroll") for (int k = 0; k < 2; ++k) \
        acc[ai][bj][m][n] = __builtin_amdgcn_mfma_f32_16x16x32_bf16(Bt[n][k], At[m][k], acc[ai][bj][m][n], 0, 0, 0); __builtin_amdgcn_s_setprio(0); } while (0)
#define PG8_WAIT_V(n) asm volatile("s_waitcnt vmcnt(" #n ")" ::: "memory")
#define PG8_WAIT_L(n) asm volatile("s_waitcnt lgkmcnt(" #n ")" ::: "memory")
#define PG8_BAR __builtin_amdgcn_s_barrier()
#define PG8_SCHED __builtin_amdgcn_sched_barrier(0)
    Unit cur, nxt; int ui = 0;
    if (!S.next(0, cur)) return;
    f32x4 acc[2][2][4][2];
#pragma unroll
    for (int a = 0; a < 2; ++a)
#pragma unroll
        for (int b = 0; b < 2; ++b)
#pragma unroll
            for (int m = 0; m < 4; ++m)
#pragma unroll
                for (int n = 0; n < 2; ++n) acc[a][b][m][n] = (f32x4){0.f, 0.f, 0.f, 0.f};
    bf16x8 At[4][2], B0[2][2], B1[2][2];
    const char* cA = (const char*)g.A + cur.aoff; const char* cB = (const char*)g.Bt + cur.boff;
    PG8_STAGE(PG8_SB(0, 0), cB, voffB); PG8_STAGE(PG8_SB(0, 1), cB + hstepB, voffB); PG8_STAGE(PG8_SA(0, 0), cA, voffA); PG8_STAGE(PG8_SA(0, 1), cA + hstepA, voffA);
    if (wr == 1) PG8_BAR;
    PG8_WAIT_V(2); PG8_BAR;
    PG8_STAGE(PG8_SB(1, 0), cB + kstep, voffB); PG8_STAGE(PG8_SA(1, 0), cA + kstepA, voffA); PG8_STAGE(PG8_SB(1, 1), cB + hstepB + kstep, voffB);
    PG8_WAIT_V(6); PG8_BAR;
    for (;;) {
        const bool has_next = S.next(ui + 1, nxt);
        const char* nA = has_next ? (const char*)g.A + nxt.aoff : cA; const char* nB = has_next ? (const char*)g.Bt + nxt.boff : cB;
        const int ntc = cur.nt ? cur.nt : nt;
        for (int t = 0; t < ntc; t += 2) {
            const bool last = (t == ntc - 2);
            const char* a1 = cA + (size_t)(t + 1) * kstepA;
            const char* a2 = last ? nA : cA + (size_t)(t + 2) * kstepA; const char* b2 = last ? nB : cB + (size_t)(t + 2) * kstep;
            const char* a3 = a2 + kstepA; const char* b3 = b2 + kstep;
            PG8_LDB(B0, 0, 0); PG8_LDB(B1, 0, 1); PG8_SCHED; PG8_LDA(At, 0, 0); PG8_STAGE(PG8_SA(1, 1), a1 + hstepA, voffA);
            PG8_WAIT_V(8); PG8_WAIT_L(0); PG8_BAR; PG8_MMA(0, 0, At, B0); PG8_MMA(0, 1, At, B1); PG8_BAR; PG8_SCHED;
            PG8_LDA(At, 0, 1); PG8_STAGE(PG8_SB(0, 0), b2, voffB); PG8_STAGE(PG8_SB(0, 1), b2 + hstepB, voffB); PG8_STAGE(PG8_SA(0, 0), a2, voffA);
            PG8_WAIT_V(8); PG8_WAIT_L(0); PG8_BAR; PG8_MMA(1, 0, At, B0); PG8_MMA(1, 1, At, B1); PG8_BAR; PG8_SCHED;
            PG8_LDB(B0, 1, 0); PG8_LDB(B1, 1, 1); PG8_SCHED; PG8_LDA(At, 1, 0); PG8_STAGE(PG8_SA(0, 1), a2 + hstepA, voffA);
            PG8_WAIT_V(8); PG8_WAIT_L(0); PG8_BAR; PG8_MMA(0, 0, At, B0); PG8_MMA(0, 1, At, B1); PG8_BAR; PG8_SCHED;
            PG8_LDA(At, 1, 1); PG8_STAGE(PG8_SB(1, 0), b3, voffB); PG8_STAGE(PG8_SB(1, 1), b3 + hstepB, voffB); PG8_STAGE(PG8_SA(1, 0), a3, voffA);
            PG8_WAIT_V(8); PG8_WAIT_L(0); PG8_BAR; PG8_MMA(1, 0, At, B0); PG8_MMA(1, 1, At, B1); PG8_BAR; PG8_SCHED;
        }
        if (MK_ALIGN_EPI) { if (wr == 0) PG8_BAR; }
        E(acc, cur, wr, wc, fr, fq);
        if (!has_next) break;
#pragma unroll
        for (int a = 0; a < 2; ++a)
#pragma unroll
            for (int b = 0; b < 2; ++b)
#pragma unroll
                for (int m = 0; m < 4; ++m)
#pragma unroll
                    for (int n = 0; n < 2; ++n) acc[a][b][m][n] = (f32x4){0.f, 0.f, 0.f, 0.f};
        cur = nxt; cA = nA; cB = nB; ++ui;
        if (MK_ALIGN_EPI) { if (wr == 1) PG8_BAR; }
    }
    PG8_WAIT_V(0);
    if (!MK_ALIGN_EPI) { if (wr == 0) PG8_BAR; }
    PG8_BAR;
#undef PG8_SA
#undef PG8_SB
#undef PG8_STAGE
#undef PG8_LDA
#undef PG8_LDB
#undef PG8_MMA
#undef PG8_WAIT_V
#undef PG8_WAIT_L
#undef PG8_BAR
#undef PG8_SCHED
}
}

typedef const f32x4 (&AccRef)[2][2][4][2];
__device__ __forceinline__ v4u pack8(const f32x4& v0, const f32x4& v1) { v4u w; w.x = cvt_pk_bf16(v0[0], v0[1]); w.y = cvt_pk_bf16(v0[2], v0[3]); w.z = cvt_pk_bf16(v1[0], v1[1]); w.w = cvt_pk_bf16(v1[2], v1[3]); return w; }

__device__ __forceinline__ void st16_wt(void* p, v4u v) {
#if MK_WT_STORES
    asm volatile("global_store_dwordx4 %0, %1, off sc1" :: "v"(p), "v"(v) : "memory");
#else
    *(v4u*)p = v;
#endif
}
struct EpiInProj {
    static constexpr bool PERM = true;
    bf16* AY; bf16* Q; bf16* Kb; bf16* V;
    __device__ __forceinline__ void operator()(AccRef acc, const pg8::Unit& u, int wr, int wc, int fr, int fq) const {
        const int row0 = u.pm * 256 + wr * 64 + fr;
        const int sel = u.pn >> 1;
#pragma unroll
        for (int ai = 0; ai < 2; ++ai)
#pragma unroll
            for (int m = 0; m < 4; ++m) {
                const int row = row0 + ai * 128 + m * 16;
#pragma unroll
                for (int bj = 0; bj < 2; ++bj) {
                    const int j0 = (u.pn & 1) * 256 + bj * 128 + wc * 32 + 8 * fq;
                    f32x4 v0 = acc[ai][bj][m][0], v1 = acc[ai][bj][m][1];
                    if (sel == 0) {
                        const int g = j0 >> 4, hh0 = j0 & 15, cr = row >> 5, s = row & 31;
                        *(v4u*)(AY + ((size_t)(g * NCRP + cr) * KY + s * 16 + hh0)) = pack8(v0, v1);
                    } else {
                        bf16* base = Q + (size_t)(sel - 1) * ((WS_K - WS_Q) / 2);
                        if (sel == 1) { v0 = v0 * QSCALE; v1 = v1 * QSCALE; }
                        *(v4u*)(base + (size_t)row * 512 + j0) = pack8(v0, v1);
                    }
                }
            }
    }
};
struct EpiS {
    static constexpr bool PERM = false;
    float* S;
    __device__ __forceinline__ void operator()(AccRef acc, const pg8::Unit& u, int wr, int wc, int fr, int fq) const {
        const int row0 = u.pm * 256 + wr * 64 + fr, col0 = wc * 32 + 4 * fq;
#pragma unroll
        for (int ai = 0; ai < 2; ++ai)
#pragma unroll
            for (int m = 0; m < 4; ++m) { float* rowp = S + (size_t)(row0 + ai * 128 + m * 16) * 256 + col0;
#pragma unroll
                for (int bj = 0; bj < 2; ++bj)
#pragma unroll
                    for (int n = 0; n < 2; ++n) *(f32x4*)(rowp + bj * 128 + n * 16) = acc[ai][bj][m][n]; }
    }
};
struct EpiY {
    static constexpr bool PERM = true;
    bf16* G;
    __device__ __forceinline__ void operator()(AccRef acc, const pg8::Unit& u, int wr, int wc, int fr, int fq) const {
        const int g = u.pm / 5, crb = (u.pm - g * 5) * 256 + wr * 64 + fr;
#pragma unroll
        for (int ai = 0; ai < 2; ++ai)
#pragma unroll
            for (int m = 0; m < 4; ++m) {
                const int cr = crb + ai * 128 + m * 16;
                if (cr < 1088) {
#pragma unroll
                    for (int bj = 0; bj < 2; ++bj) {
                        const int nl = u.pn * 256 + bj * 128 + wc * 32 + 8 * fq, t = nl >> 4, hh0 = nl & 15;
                        f32x4 v0 = acc[ai][bj][m][0], v1 = acc[ai][bj][m][1];
#pragma unroll
                        for (int j = 0; j < 4; ++j) { v0[j] = gelu_tanh(v0[j]); v1[j] = gelu_tanh(v1[j]); }
                        *(v4u*)(G + (size_t)(cr * 32 + t) * 512 + g * 16 + hh0) = pack8(v0, v1);
                    }
                }
            }
    }
};
struct EpiGlu {
    static constexpr bool PERM = true;
    const bf16* G; const float* bias; bf16* YA;
    __device__ __forceinline__ void operator()(AccRef acc, const pg8::Unit& u, int wr, int wc, int fr, int fq) const {
        const int row0 = u.pm * 256 + wr * 64 + fr;
#pragma unroll
        for (int ai = 0; ai < 2; ++ai)
#pragma unroll
            for (int m = 0; m < 4; ++m) {
                const int row = row0 + ai * 128 + m * 16;
#pragma unroll
                for (int bj = 0; bj < 2; ++bj) {
                    const int c0 = u.pn * 256 + bj * 128 + wc * 32 + 8 * fq;
                    const v4u gv = *(const v4u*)(G + (size_t)row * 512 + c0);
                    const f32x4 b0 = *(const f32x4*)(bias + c0), b1 = *(const f32x4*)(bias + c0 + 4);
                    f32x4 v0 = acc[ai][bj][m][0] + b0, v1 = acc[ai][bj][m][1] + b1;
                    const float gg[8] = {bflo(gv.x), bfhi(gv.x), bflo(gv.y), bfhi(gv.y), bflo(gv.z), bfhi(gv.z), bflo(gv.w), bfhi(gv.w)};
#pragma unroll
                    for (int j = 0; j < 4; ++j) { v0[j] = gg[j] * sigmoidf_(v0[j]); v1[j] = gg[4 + j] * sigmoidf_(v1[j]); }
                    *(v4u*)(YA + (size_t)row * 1024 + c0) = pack8(v0, v1);
                }
            }
    }
};
struct EpiRes {
    static constexpr bool PERM = false;
    float* X; const float* gate; float* slab;
    __device__ __forceinline__ void operator()(AccRef acc, const pg8::Unit& u, int wr, int wc, int fr, int fq) const {
        const int row0 = u.pm * 256 + wr * 64 + fr, col0 = u.pn * 256 + wc * 32 + 4 * fq;
        const int rb = u.pm * 256; const int bidx = rb < MLAT ? (rb >> 12) : 8;
        const float* gp = gate + (size_t)bidx * 6144 + col0;
        f32x4 gv[2][2];
#pragma unroll
        for (int bj = 0; bj < 2; ++bj)
#pragma unroll
            for (int n = 0; n < 2; ++n) gv[bj][n] = *(const f32x4*)(gp + bj * 128 + n * 16);
        if (u.atomic) {
            float* sl = slab + (size_t)(u.atomic - 1) * MCTX * 1024;
#pragma unroll
            for (int ai = 0; ai < 2; ++ai)
#pragma unroll
                for (int m = 0; m < 4; ++m) { float* rowp = sl + (size_t)(row0 - MLAT + ai * 128 + m * 16) * 1024 + col0;
#pragma unroll
                    for (int bj = 0; bj < 2; ++bj)
#pragma unroll
                        for (int n = 0; n < 2; ++n) *(f32x4*)(rowp + bj * 128 + n * 16) = acc[ai][bj][m][n]; }
        } else {
#pragma unroll
            for (int ai = 0; ai < 2; ++ai)
#pragma unroll
                for (int m = 0; m < 4; ++m) { float* rowp = X + (size_t)(row0 + ai * 128 + m * 16) * 1024 + col0;
#pragma unroll
                    for (int bj = 0; bj < 2; ++bj)
#pragma unroll
                        for (int n = 0; n < 2; ++n) { f32x4* p = (f32x4*)(rowp + bj * 128 + n * 16); *p = *p + gv[bj][n] * acc[ai][bj][m][n]; }
                    asm volatile("" ::: "memory"); }
        }
    }
};
struct EpiSwiGlu {
    static constexpr bool PERM = true;
    bf16* O; int ldo; int row_sub; int blocked;
    __device__ __forceinline__ void operator()(AccRef acc, const pg8::Unit& u, int wr, int wc, int fr, int fq) const {
        const int row0 = u.pm * 256 - row_sub + wr * 64 + fr, c0 = u.pn * 128 + wc * 32 + 8 * fq;
#pragma unroll
        for (int ai = 0; ai < 2; ++ai)
#pragma unroll
            for (int m = 0; m < 4; ++m) {
                f32x4 a0 = acc[ai][0][m][0], a1 = acc[ai][0][m][1]; const f32x4 b0 = acc[ai][1][m][0], b1 = acc[ai][1][m][1];
#pragma unroll
                for (int j = 0; j < 4; ++j) { a0[j] = siluf_(a0[j]) * b0[j]; a1[j] = siluf_(a1[j]) * b1[j]; }
                const int row = row0 + ai * 128 + m * 16;
                bf16* p = blocked ? O + ((size_t)((row >> 8) * (ldo >> 6) + (c0 >> 6)) * 256 + (row & 255)) * 64 + (c0 & 63) : O + (size_t)row * ldo + c0;
                st16_wt(p, pack8(a0, a1));
            }
    }
};
struct EpiPlain {
    static constexpr bool PERM = true;
    bf16* O; int ldo; bf16* O2; int xpm0;
    __device__ __forceinline__ void operator()(AccRef acc, const pg8::Unit& u, int wr, int wc, int fr, int fq) const {
        const int rt = wr * 64 + fr, ct = wc * 32 + 8 * fq;
        bf16* base; int ld;
        if (u.atomic == 2) { base = O2 + (size_t)((u.pm - xpm0) * 4 + u.pn) * 65536 + (size_t)rt * 256 + ct; ld = 256; }
        else { base = O + (size_t)(u.pm * 256 + rt) * ldo + u.pn * 256 + ct; ld = ldo; }
#pragma unroll
        for (int ai = 0; ai < 2; ++ai)
#pragma unroll
            for (int m = 0; m < 4; ++m)
#pragma unroll
                for (int bj = 0; bj < 2; ++bj)
                    *(v4u*)(base + (size_t)(ai * 128 + m * 16) * ld + bj * 128) = pack8(acc[ai][bj][m][0], acc[ai][bj][m][1]);
    }
};

#define XB_TMO      128
#define XB_XCNT(j)  (256  + 64 * (j))
#define XB_XSUB(j)  (1280 + 64 * (j))
#define XB_XGEN(j)  (2304 + 64 * (j))
#define XB_TOP      3328
#define XB_TOPGEN   3392
#define XCD_BAR_WORDS 3456
#define XB_SPIN_CAP (1u << 18)
__device__ __forceinline__ unsigned xb_ld(unsigned* p)              { return __hip_atomic_load(p, __ATOMIC_RELAXED, __HIP_MEMORY_SCOPE_AGENT); }
__device__ __forceinline__ unsigned xb_add(unsigned* p, unsigned v) { return __hip_atomic_fetch_add(p, v, __ATOMIC_RELAXED, __HIP_MEMORY_SCOPE_AGENT); }
__device__ __forceinline__ unsigned xb_xcc_id() { return (unsigned)__builtin_amdgcn_s_getreg((3 << 11) | 20) & 0xFu; }
#define XB_SPIN(cond, bar) do { unsigned _sp = 0; while (cond) { __builtin_amdgcn_s_sleep(1); \
    if ((++_sp & 255u) == 0u) { if (xb_ld(&(bar)[XB_TMO])) break; if (_sp > XB_SPIN_CAP) { atomicAdd(&(bar)[XB_TMO], 1u); break; } } } } while (0)
struct XcdBarrier { unsigned* bar; unsigned x; volatile LAS unsigned* st; };
__device__ __forceinline__ XcdBarrier xcd_barrier_post(unsigned* bar, volatile LAS unsigned* st) {
    XcdBarrier b; b.bar = bar; b.x = xb_xcc_id(); b.st = st;
    if (threadIdx.x == 0) (void)xb_add(&bar[XB_XCNT(b.x)], 1u);
    return b;
}
__device__ __forceinline__ void xcd_barrier_complete(unsigned* bar, unsigned x, unsigned& nloc, unsigned& nx) {
    const unsigned G = gridDim.x * gridDim.y * gridDim.z;
    unsigned sum, cnt, mine, sp = 0u;
    for (;;) {
        sum = 0u; cnt = 0u; mine = 0u;
#pragma unroll
        for (unsigned j = 0; j < 16; ++j) { const unsigned c = xb_ld(&bar[XB_XCNT(j)]); sum += c; cnt += (c > 0u) ? 1u : 0u; mine = (j == x) ? c : mine; }
        if (sum == G) break;
        __builtin_amdgcn_s_sleep(1);
        if ((++sp & 255u) == 0u) { if (xb_ld(&bar[XB_TMO])) break; if (sp > XB_SPIN_CAP) { atomicAdd(&bar[XB_TMO], 1u); break; } }
    }
    nloc = mine > 0u ? mine : 1u; nx = cnt > 0u ? cnt : 1u;
}
__device__ __forceinline__ void xcd_barrier(const XcdBarrier& b) {
    asm volatile("s_waitcnt vmcnt(0)" ::: "memory");
    __syncthreads();
    if (lt_tid() == 0) {
        unsigned* bar = b.bar;
        __builtin_amdgcn_s_waitcnt(0);
        unsigned nloc = b.st[0], nx = b.st[1];
        if (nloc == 0u) { xcd_barrier_complete(bar, b.x, nloc, nx); b.st[0] = nloc; b.st[1] = nx; }
        const unsigned old = xb_add(&bar[XB_XSUB(b.x)], 1u);
        const unsigned gen = old / nloc;
        if (old + 1u == (gen + 1u) * nloc) {
            __builtin_amdgcn_fence(__ATOMIC_RELEASE, "agent");
            asm volatile("s_waitcnt vmcnt(0)" ::: "memory");
            const unsigned og = xb_add(&bar[XB_TOP], 1u);
            const unsigned tg = og / nx;
            if (og + 1u == (tg + 1u) * nx) xb_add(&bar[XB_TOPGEN], 1u);
            else XB_SPIN(xb_ld(&bar[XB_TOPGEN]) == tg, bar);
            __builtin_amdgcn_fence(__ATOMIC_ACQUIRE, "agent");
            xb_add(&bar[XB_XGEN(b.x)], 1u);
            asm volatile("s_waitcnt vmcnt(0)" ::: "memory");
        } else {
            XB_SPIN(xb_ld(&bar[XB_XGEN(b.x)]) == gen, bar);
            __builtin_amdgcn_fence(__ATOMIC_ACQUIRE, "agent");
            asm volatile("s_waitcnt vmcnt(0)" ::: "memory");
        }
    }
    __syncthreads();
}

struct XbTok { unsigned gen, tg; int role; };
__device__ __forceinline__ XbTok xcd_arrive(const XcdBarrier& b) {
    asm volatile("s_waitcnt vmcnt(0)" ::: "memory");
    __syncthreads();
    XbTok t; t.gen = 0u; t.tg = 0u; t.role = 0;
    if (lt_tid() == 0) {
        unsigned* bar = b.bar;
        __builtin_amdgcn_s_waitcnt(0);
        unsigned nloc = b.st[0], nx = b.st[1];
        if (nloc == 0u) { xcd_barrier_complete(bar, b.x, nloc, nx); b.st[0] = nloc; b.st[1] = nx; }
        const unsigned old = xb_add(&bar[XB_XSUB(b.x)], 1u);
        t.gen = old / nloc;
        if (old + 1u == (t.gen + 1u) * nloc) {
            __builtin_amdgcn_fence(__ATOMIC_RELEASE, "agent");
            asm volatile("s_waitcnt vmcnt(0)" ::: "memory");
            const unsigned og = xb_add(&bar[XB_TOP], 1u);
            t.tg = og / nx;
            if (og + 1u == (t.tg + 1u) * nx) { xb_add(&bar[XB_TOPGEN], 1u); t.role = 2; } else t.role = 1;
        }
    }
    return t;
}
__device__ __forceinline__ void xcd_wait(const XcdBarrier& b, const XbTok& t) {
    if (lt_tid() == 0) {
        unsigned* bar = b.bar;
        if (t.role) {
            if (t.role == 1) XB_SPIN(xb_ld(&bar[XB_TOPGEN]) == t.tg, bar);
            __builtin_amdgcn_fence(__ATOMIC_ACQUIRE, "agent");
            xb_add(&bar[XB_XGEN(b.x)], 1u);
            asm volatile("s_waitcnt vmcnt(0)" ::: "memory");
        } else {
            XB_SPIN(xb_ld(&bar[XB_XGEN(b.x)]) == t.gen, bar);
            __builtin_amdgcn_fence(__ATOMIC_ACQUIRE, "agent");
            asm volatile("s_waitcnt vmcnt(0)" ::: "memory");
        }
    }
    __syncthreads();
}

struct Args { const float* in[29]; float* out; unsigned char* ws; int ph_lo, ph_hi; };
enum InIdx { I_X = 0, I_C, I_CTX, I_CCTX, I_WMOD, I_BMOD, I_GMIX, I_GFFN, I_WIN, I_WOUT, I_ARE, I_AIM, I_LOGSTEP, I_BRE, I_BIM, I_CRE, I_CIM, I_SSMD, I_GLUW, I_GLUB, I_RPB,
             I_FW1, I_FW3, I_FW2, I_ROUTER, I_MW1, I_MW3, I_MW2, I_GFINAL };
struct Ctx {
    LAS unsigned char* lds; unsigned char* ws; gu32* ctl;
    int tid, lane, wave, vcu, G;
    const float* const* in; float* out;
};
__device__ __forceinline__ int batch_slot(int m) { return m < MLAT ? (m >> 12) : 8; }

__device__ __forceinline__ void mod_phase(Ctx& F) {
    F.tid = lt_tid(); F.lane = F.tid & 63;
    LAS float* sc = (LAS float*)F.lds;
    LAS float* red = sc + 9 * 1024;
    const float* c = F.in[I_C]; const float* cc = F.in[I_CCTX];
    for (int i = F.tid; i < 9 * 1024; i += 512) { const float v = i < 8192 ? c[i] : cc[i - 8192]; sc[i] = siluf_(v); }
    __syncthreads();
    float* mod = (float*)(F.ws + WS_MOD);
    const int col = F.tid & 31, kg = F.tid >> 5;
    for (int it = F.vcu; it < 4 * 192; it += F.G) {
        const int l = it / 192, c0 = (it % 192) * 32;
        const float* W = F.in[I_WMOD] + (size_t)l * 1024 * 6144 + c0 + col;
        float acc[9];
#pragma unroll
        for (int r = 0; r < 9; ++r) acc[r] = 0.f;
#pragma unroll 4
        for (int kk = 0; kk < 64; ++kk) { const int k = kg * 64 + kk; const float w = W[(size_t)k * 6144];
#pragma unroll
            for (int r = 0; r < 9; ++r) acc[r] += sc[r * 1024 + k] * w; }
#pragma unroll
        for (int r = 0; r < 9; ++r) red[(kg * 9 + r) * 32 + col] = acc[r];
        __syncthreads();
        if (F.tid < 288) { const int r = F.tid >> 5; float s = F.in[I_BMOD][l * 6144 + c0 + col];
#pragma unroll
            for (int q = 0; q < 16; ++q) s += red[(q * 9 + r) * 32 + col];
            mod[((size_t)l * 9 + r) * 6144 + c0 + col] = s; }
        __syncthreads();
    }
}

__device__ __forceinline__ void tr_item(const float* W, int K, int N, bf16* WT, int mode, LAS float* scr, int item, int lane) {
    const int nblk = N / 64, kb = item / nblk, nb = item % nblk, k0 = 64 * kb, n0 = 64 * nb;
    const int drow0 = mode == 0 ? n0 : ((n0 >> 7) * 256 + (mode == 2 ? 128 : 0) + (n0 & 127));
    const float* src = W + (size_t)(k0 + (lane >> 4)) * N + n0 + 4 * (lane & 15);
    f32x4 v[16];
#pragma unroll
    for (int i = 0; i < 16; ++i) v[i] = *(const GAS f32x4*)(src + (size_t)(4 * i) * N);
#pragma unroll
    for (int i = 0; i < 16; ++i) { LAS float* d = scr + (4 * i + (lane >> 4)) * 65 + 4 * (lane & 15); d[0] = v[i][0]; d[1] = v[i][1]; d[2] = v[i][2]; d[3] = v[i][3]; }
    LDS_WAIT(); asm volatile("" ::: "memory");
    const int c = lane & 7;
#pragma unroll
    for (int j = 0; j < 8; ++j) { const int n = (lane >> 3) + 8 * j; const LAS float* s = scr + (8 * c) * 65 + n;
        v4u o; o.x = pk2(s[0 * 65], s[1 * 65]); o.y = pk2(s[2 * 65], s[3 * 65]); o.z = pk2(s[4 * 65], s[5 * 65]); o.w = pk2(s[6 * 65], s[7 * 65]);
        *(GAS v4u*)(WT + (size_t)(drow0 + n) * K + k0 + 8 * c) = o; }
    LDS_WAIT(); asm volatile("" ::: "memory");
}
constexpr int CV_IN = 16 * 32, CV_OUT = 16 * 16, CV_GLU = 8 * 8, CV_D13 = 16 * 44, CV_D2 = 44 * 16, CV_M13 = 16 * 56, CV_M2 = 56 * 16;
__device__ __forceinline__ int conv_ntiles(int l) { return CV_IN + CV_OUT + CV_GLU + ((l & 1) ? 8 * (2 * CV_M13 + CV_M2) : (2 * CV_D13 + CV_D2)); }
__device__ __forceinline__ void conv_tile(Ctx& F, int l, int r, LAS float* scr, int lane) {
    const bool moe = (l & 1) != 0; const int li = l >> 1;
    bf16* W13 = (bf16*)(F.ws + ws_w13(l)); bf16* W2 = (bf16*)(F.ws + ws_w2(l));
    if (r < CV_IN) { tr_item(F.in[I_WIN] + (size_t)l * 1024 * 2048, 1024, 2048, (bf16*)(F.ws + ws_win(l)), 0, scr, r, lane); return; } r -= CV_IN;
    if (r < CV_OUT) { tr_item(F.in[I_WOUT] + (size_t)l * 1024 * 1024, 1024, 1024, (bf16*)(F.ws + ws_wout(l)), 0, scr, r, lane); return; } r -= CV_OUT;
    if (r < CV_GLU) { tr_item(F.in[I_GLUW] + (size_t)l * 512 * 512, 512, 512, (bf16*)(F.ws + ws_wglu(l)), 0, scr, r, lane); return; } r -= CV_GLU;
    if (!moe) {
        if (r < CV_D13) { tr_item(F.in[I_FW1] + (size_t)li * 1024 * DFF, 1024, DFF, W13, 1, scr, r, lane); return; } r -= CV_D13;
        if (r < CV_D13) { tr_item(F.in[I_FW3] + (size_t)li * 1024 * DFF, 1024, DFF, W13, 2, scr, r, lane); return; } r -= CV_D13;
        tr_item(F.in[I_FW2] + (size_t)li * DFF * 1024, DFF, 1024, W2, 0, scr, r, lane);
    } else {
        const int per = 2 * CV_M13 + CV_M2, e = r / per; r -= e * per;
        const size_t eo = (size_t)(li * 8 + e) * 1024 * DFE;
        if (r < CV_M13) { tr_item(F.in[I_MW1] + eo, 1024, DFE, W13 + (size_t)e * 7168 * 1024, 1, scr, r, lane); return; } r -= CV_M13;
        if (r < CV_M13) { tr_item(F.in[I_MW3] + eo, 1024, DFE, W13 + (size_t)e * 7168 * 1024, 2, scr, r, lane); return; } r -= CV_M13;
        tr_item(F.in[I_MW2] + eo, DFE, 1024, W2 + (size_t)e * 1024 * DFE, 0, scr, r, lane);
    }
}
__device__ __forceinline__ void wconv_drain(Ctx& F, int l, unsigned x) {
    volatile LAS int* bc = (volatile LAS int*)(F.lds + LDSCTL_OFF + 512);
    const int n = conv_ntiles(l);
    for (int rr = 0; rr < 8; ++rr) {
        const int r = (rr + (int)(x & 7u)) & 7;
        for (;;) {
            __syncthreads();
            if (threadIdx.x == 0) { gu32* q = F.ctl + CW_Q + 64 * (l * 8 + r); int c = 0x7fffff;
                if ((int)((__hip_atomic_load(q, RLX_AGENT) * 8u + (unsigned)r) * 8u) < n) c = (int)__hip_atomic_fetch_add(q, 1u, RLX_AGENT);
                bc[0] = c; }
            __syncthreads();
            const int t = (bc[0] * 8 + r) * 8 + F.wave;
            if ((bc[0] * 8 + r) * 8 >= n) break;
            if (t < n) conv_tile(F, l, t, (LAS float*)(F.lds + F.wave * 16640), lt_tid() & 63);
        }
    }
}
__device__ __forceinline__ void wconv_phase(Ctx& F, int l, int t_begin) {
    const int lane = lt_tid() & 63;
    LAS float* scr = (LAS float*)(F.lds + F.wave * 16640);
    const int gw = F.vcu * 8 + F.wave, NGW = F.G * 8, n = conv_ntiles(l);
    for (int it = t_begin + gw; it < n; it += NGW) conv_tile(F, l, it, scr, lane);
}

__device__ __forceinline__ void sincos_red(float x, float& s, float& c) {
    const float k = rintf(x * 0.15915494309189535f);
    float r = fmaf(-k, 6.28318548202514648f, x); r = fmaf(-k, -1.7484555e-07f, r);
    s = __sinf(r); c = __cosf(r);
}
#define CCI(dir, hh, p) ((((dir) * 16 + (hh)) * 65 + (p)) * 2)
#define KTI(dir, tau, hh, h) (((((dir) * 16 + (hh)) * 16 + (h)) * 32) + (tau))
__device__ __forceinline__ void ssm_prepA(Ctx& F, int l, int g, int part8) {
    F.tid = lt_tid(); F.lane = F.tid & 63;
    LAS float* LAM = (LAS float*)F.lds;
    LAS float* CC = LAM + 8448;
    LAS float* BB = CC + 4160;
    const int tid = F.tid;
    __syncthreads();
    if (tid < 128) {
        const int dir = tid >> 6, p = tid & 63; const int pi = ((l * 2 + dir) * 32 + g) * 64 + p;
        const float are = fminf(F.in[I_ARE][pi], -1e-4f), aim = F.in[I_AIM][pi];
        const float dt = __expf(F.in[I_LOGSTEP][(l * 2 + dir) * 32 + g]);
        const float th = aim * dt, ad = are * dt;
        for (int e = 0; e <= 32; ++e) { float sn, cs; sincos_red(th * (float)e, sn, cs); const float mg = __expf(ad * (float)e);
            LAM[((dir * 64 + p) * 33 + e) * 2] = mg * cs; LAM[((dir * 64 + p) * 33 + e) * 2 + 1] = mg * sn; }
        float s1, c1; sincos_red(th, s1, c1); const float m1 = __expf(ad); const float lre = m1 * c1, lim = m1 * s1;
        const float den = are * are + aim * aim;
        const float zre = ((lre - 1.f) * are + lim * aim) / den, zim = (lim * are - (lre - 1.f) * aim) / den;
        for (int h = 0; h < 16; ++h) { const float br = F.in[I_BRE][(size_t)pi * 16 + h], bi = F.in[I_BIM][(size_t)pi * 16 + h];
            BB[((dir * 64 + p) * 16 + h) * 2] = zre * br - zim * bi; BB[((dir * 64 + p) * 16 + h) * 2 + 1] = zre * bi + zim * br; }
    }
    for (int idx = tid; idx < 2048; idx += 512) { const int dir = idx >> 10, rem = idx & 1023, hh = rem >> 6, p = rem & 63; const size_t gi = ((size_t)((l * 2 + dir) * 32 + g)) * 1024 + rem;
        CC[CCI(dir, hh, p)] = F.in[I_CRE][gi]; CC[CCI(dir, hh, p) + 1] = F.in[I_CIM][gi]; }
    __syncthreads();
    {
        const int dir = tid >> 8, hh = (tid >> 4) & 15, h = tid & 15, t0 = 4 * part8;
        float a0 = 0.f, a1 = 0.f, a2 = 0.f, a3 = 0.f;
        for (int p = 0; p < 64; ++p) {
            const float cr = CC[CCI(dir, hh, p)], ci = CC[CCI(dir, hh, p) + 1];
            const float br = BB[((dir * 64 + p) * 16 + h) * 2], bi = BB[((dir * 64 + p) * 16 + h) * 2 + 1];
            const float gr = cr * br - ci * bi, gi = cr * bi + ci * br;
            const LAS float* lp = LAM + ((dir * 64 + p) * 33 + t0) * 2;
            a0 += gr * lp[0] - gi * lp[1]; a1 += gr * lp[2] - gi * lp[3]; a2 += gr * lp[4] - gi * lp[5]; a3 += gr * lp[6] - gi * lp[7];
        }
        float* KTG = (float*)(F.ws + WS_KTG) + (size_t)g * 16384;
        *(f32x4*)(KTG + KTI(dir, t0, hh, h)) = (f32x4){a0, a1, a2, a3};
    }
    bf16* BtS = (bf16*)(F.ws + WS_BTS) + (size_t)g * 256 * 512;
    bf16* BtY = (bf16*)(F.ws + WS_BTY) + (size_t)g * 512 * KY;
    for (int task = tid; task < 32 * 32; task += 512) {
        const int n = part8 * 32 + (task >> 5), s = task & 31, dir = n >> 7, part = (n >> 6) & 1, p = n & 63, e = dir ? s : 31 - s;
        const float lr = LAM[((dir * 64 + p) * 33 + e) * 2], li = LAM[((dir * 64 + p) * 33 + e) * 2 + 1];
        float v[16];
#pragma unroll
        for (int h = 0; h < 16; ++h) { const float br = BB[((dir * 64 + p) * 16 + h) * 2], bi = BB[((dir * 64 + p) * 16 + h) * 2 + 1]; v[h] = part ? (lr * bi + li * br) : (lr * br - li * bi); }
        v4u o0, o1; o0.x = pk2(v[0], v[1]); o0.y = pk2(v[2], v[3]); o0.z = pk2(v[4], v[5]); o0.w = pk2(v[6], v[7]); o1.x = pk2(v[8], v[9]); o1.y = pk2(v[10], v[11]); o1.z = pk2(v[12], v[13]); o1.w = pk2(v[14], v[15]);
        v4u* dst = (v4u*)(BtS + (size_t)n * 512 + s * 16); dst[0] = o0; dst[1] = o1;
    }
    for (int task = tid; task < 64 * 16; task += 512) {
        const int n = part8 * 64 + (task >> 4), ch = task & 15, t = n >> 4, hh = n & 15, dir = ch >> 3, part = (ch >> 2) & 1, p0 = (ch & 3) * 16, e = dir ? 32 - t : t + 1;
        float v[16];
#pragma unroll
        for (int j = 0; j < 16; ++j) { const int p = p0 + j; const float cr = CC[CCI(dir, hh, p)], ci = CC[CCI(dir, hh, p) + 1];
            const float lr = LAM[((dir * 64 + p) * 33 + e) * 2], li = LAM[((dir * 64 + p) * 33 + e) * 2 + 1]; v[j] = part ? -(cr * li + ci * lr) : (cr * lr - ci * li); }
        v4u o0, o1; o0.x = pk2(v[0], v[1]); o0.y = pk2(v[2], v[3]); o0.z = pk2(v[4], v[5]); o0.w = pk2(v[6], v[7]); o1.x = pk2(v[8], v[9]); o1.y = pk2(v[10], v[11]); o1.z = pk2(v[12], v[13]); o1.w = pk2(v[14], v[15]);
        v4u* dst = (v4u*)(BtY + (size_t)n * KY + 512 + ch * 16); dst[0] = o0; dst[1] = o1;
    }
    __syncthreads();
}
__device__ __forceinline__ void ssm_prepB(Ctx& F, int l, int g, int part8) {
    F.tid = lt_tid(); F.lane = F.tid & 63;
    LAS float* KT = (LAS float*)F.lds;
    const int tid = F.tid;
    __syncthreads();
    const float* KTG = (const float*)(F.ws + WS_KTG) + (size_t)g * 16384;
    for (int i = tid; i < 4096; i += 512) *(LAS f32x4*)(KT + 4 * i) = *(const f32x4*)(KTG + 4 * i);
    __syncthreads();
    bf16* BtY = (bf16*)(F.ws + WS_BTY) + (size_t)g * 512 * KY;
    const float* dsk = F.in[I_SSMD] + l * 512 + g * 16;
    for (int task = tid; task < 64 * 32; task += 512) {
        const int n = part8 * 64 + (task >> 5), s = task & 31, t = n >> 4, hh = n & 15;
        float v[16];
#pragma unroll
        for (int h = 0; h < 16; ++h) { float x = 0.f; if (s <= t) x += KT[KTI(0, t - s, hh, h)]; if (s >= t) x += KT[KTI(1, s - t, hh, h)]; if (s == t && h == hh) x += dsk[hh]; v[h] = x; }
        v4u o0, o1; o0.x = pk2(v[0], v[1]); o0.y = pk2(v[2], v[3]); o0.z = pk2(v[4], v[5]); o0.w = pk2(v[6], v[7]); o1.x = pk2(v[8], v[9]); o1.y = pk2(v[10], v[11]); o1.z = pk2(v[12], v[13]); o1.w = pk2(v[14], v[15]);
        v4u* dst = (v4u*)(BtY + (size_t)n * KY + s * 16); dst[0] = o0; dst[1] = o1;
    }
    __syncthreads();
}
#undef CCI
#undef KTI

__device__ __forceinline__ void moe_seg(const unsigned* cnt, int (&segp)[9]) {
    int acc = 0;
#pragma unroll
    for (int e = 0; e < 8; ++e) { segp[e] = acc; acc += ((int)cnt[e] + 255) >> 8; }
    segp[8] = acc;
}
template <int MODE>
__device__ __forceinline__ void norm_phase(Ctx& F, int l, int M, bool src_in, bool combine, bool router, const float* slab_gate, int nparts) {
    F.tid = lt_tid(); F.lane = F.tid & 63;
    const int gw = F.vcu * 8 + F.wave, NGW = F.G * 8, lane = F.lane;
    float* X = (float*)(F.ws + WS_X); bf16* HB = (bf16*)(F.ws + WS_HB);
    const float* mod = (const float*)(F.ws + WS_MOD);
    const float* gain = MODE == 0 ? F.in[I_GMIX] + l * 1024 : (MODE == 1 ? F.in[I_GFFN] + l * 1024 : F.in[I_GFINAL]);
    const int* route_e = (const int*)(F.ws + WS_ROUTE); const f32x2* route_g = (const f32x2*)(F.ws + WS_ROUTE + 256 * 1024); const int* slot_of = (const int*)(F.ws + WS_ROUTE + 576 * 1024);
    int* route_e_w = (int*)(F.ws + WS_ROUTE); f32x2* route_g_w = (f32x2*)(F.ws + WS_ROUTE + 256 * 1024);
    const bf16* YS = (const bf16*)(F.ws + WS_YS); const bf16* YS2 = (const bf16*)(F.ws + WS_SLAB);
    int m2_pm0 = -1;
    if (combine && MK_SPLIT_M2) { int segp_[9]; moe_seg((const unsigned*)F.ctl + CW_CNT + ((l - 1) >> 1) * 16, segp_); const int P_ = segp_[8], Pm_ = (P_ >> 6) << 6, xl_ = P_ - Pm_; if (xl_ > 0 && xl_ <= 32 && F.G == 256) m2_pm0 = Pm_; }
    LAS int* lcnt = (LAS int*)(F.lds);
    float rw[4][4][8];
    if (router) {
        if (F.tid < 8) lcnt[F.tid] = 0;
        __syncthreads();
        const float* R = F.in[I_ROUTER] + (size_t)(l >> 1) * 1024 * 8;
#pragma unroll
        for (int j = 0; j < 4; ++j)
#pragma unroll
            for (int i = 0; i < 4; ++i) { const f32x4 a = *(const f32x4*)(R + (size_t)(256 * j + 4 * lane + i) * 8), b = *(const f32x4*)(R + (size_t)(256 * j + 4 * lane + i) * 8 + 4);
                rw[j][i][0] = a[0]; rw[j][i][1] = a[1]; rw[j][i][2] = a[2]; rw[j][i][3] = a[3]; rw[j][i][4] = b[0]; rw[j][i][5] = b[1]; rw[j][i][6] = b[2]; rw[j][i][7] = b[3]; }
    }
    f32x4 vn[4]; int s0n = 0, s1n = 0; f32x2 ggn = (f32x2){0.f, 0.f};
#pragma unroll
    for (int j = 0; j < 4; ++j) vn[j] = (f32x4){0.f, 0.f, 0.f, 0.f};
#define NORM_PREFETCH(mm) do { const int m_ = (mm); if (m_ < M) { \
        const float* srow_ = src_in ? (m_ < MLAT ? F.in[I_X] + (size_t)m_ * 1024 : F.in[I_CTX] + (size_t)(m_ - MLAT) * 1024) : X + (size_t)m_ * 1024; \
        _Pragma("unroll") for (int j = 0; j < 4; ++j) vn[j] = *(const f32x4*)(srow_ + 256 * j + 4 * lane); \
        if (combine) { s0n = slot_of[2 * m_]; s1n = slot_of[2 * m_ + 1]; ggn = route_g[m_]; } } } while (0)
    NORM_PREFETCH(gw);
    for (int m = gw; m < M; m += NGW) {
        const int bs = batch_slot(m);
        f32x4 v[4];
#pragma unroll
        for (int j = 0; j < 4; ++j) v[j] = vn[j];
        const int s0 = s0n, s1 = s1n; const f32x2 gg = ggn;
        v2u y0r[4], y1r[4];
        v2u y0b[4], y1b[4]; bool sp0 = false, sp1 = false;
        if (combine) {
#pragma unroll
            for (int j = 0; j < 4; ++j) { y0r[j] = *(const v2u*)(YS + (size_t)s0 * 1024 + 256 * j + 4 * lane); y1r[j] = *(const v2u*)(YS + (size_t)s1 * 1024 + 256 * j + 4 * lane); }
            sp0 = m2_pm0 >= 0 && (s0 >> 8) >= m2_pm0; sp1 = m2_pm0 >= 0 && (s1 >> 8) >= m2_pm0;
            if (sp0) {
#pragma unroll
                for (int j = 0; j < 4; ++j) y0b[j] = *(const v2u*)(YS2 + (size_t)(((s0 >> 8) - m2_pm0) * 4 + j) * 65536 + (size_t)(s0 & 255) * 256 + 4 * lane);
            }
            if (sp1) {
#pragma unroll
                for (int j = 0; j < 4; ++j) y1b[j] = *(const v2u*)(YS2 + (size_t)(((s1 >> 8) - m2_pm0) * 4 + j) * 65536 + (size_t)(s1 & 255) * 256 + 4 * lane);
            }
        }
        NORM_PREFETCH(m + NGW);
        if (combine) {
            const float* gt2 = mod + ((size_t)(l - 1) * 9 + bs) * 6144 + 5 * 1024;
#pragma unroll
            for (int j = 0; j < 4; ++j) { const v2u y0 = y0r[j], y1 = y1r[j];
                const f32x4 gt = *(const f32x4*)(gt2 + 256 * j + 4 * lane);
                f32x4 f; f[0] = gg[0] * bflo(y0.x) + gg[1] * bflo(y1.x); f[1] = gg[0] * bfhi(y0.x) + gg[1] * bfhi(y1.x); f[2] = gg[0] * bflo(y0.y) + gg[1] * bflo(y1.y); f[3] = gg[0] * bfhi(y0.y) + gg[1] * bfhi(y1.y);
                if (sp0) { f[0] += gg[0] * bflo(y0b[j].x); f[1] += gg[0] * bfhi(y0b[j].x); f[2] += gg[0] * bflo(y0b[j].y); f[3] += gg[0] * bfhi(y0b[j].y); }
                if (sp1) { f[0] += gg[1] * bflo(y1b[j].x); f[1] += gg[1] * bfhi(y1b[j].x); f[2] += gg[1] * bflo(y1b[j].y); f[3] += gg[1] * bfhi(y1b[j].y); }
                v[j] = v[j] + gt * f; }
        }
        const bool addslab = slab_gate != nullptr && m >= MLAT;
        if (addslab) {
            const float* sl = (const float*)(F.ws + WS_SLAB) + (size_t)(m - MLAT) * 1024;
#pragma unroll
            for (int j = 0; j < 4; ++j) { f32x4 a = *(const f32x4*)(sl + 256 * j + 4 * lane);
                for (int p = 1; p < nparts; ++p) a = a + *(const f32x4*)(sl + (size_t)p * MCTX * 1024 + 256 * j + 4 * lane);
                v[j] = v[j] + *(const f32x4*)(slab_gate + 256 * j + 4 * lane) * a; }
        }
        if (src_in || combine || addslab) {
#pragma unroll
            for (int j = 0; j < 4; ++j) *(f32x4*)(X + (size_t)m * 1024 + 256 * j + 4 * lane) = v[j];
        }
        float ss = 0.f;
#pragma unroll
        for (int j = 0; j < 4; ++j) ss += (v[j][0] * v[j][0] + v[j][1] * v[j][1]) + (v[j][2] * v[j][2] + v[j][3] * v[j][3]);
        const float rstd = 1.0f / sqrtf(wave_sum(ss) * (1.0f / 1024.0f) + NORM_EPS);
        if (MODE == 2) {
#pragma unroll
            for (int j = 0; j < 4; ++j) { const f32x4 gv = *(const f32x4*)(gain + 256 * j + 4 * lane); *(f32x4*)(F.out + (size_t)m * 1024 + 256 * j + 4 * lane) = v[j] * rstd * gv; }
        } else {
            const float* mb = mod + ((size_t)l * 9 + bs) * 6144 + (MODE == 0 ? 0 : 3 * 1024);
            float lg[8];
#pragma unroll
            for (int e = 0; e < 8; ++e) lg[e] = 0.f;
#pragma unroll
            for (int j = 0; j < 4; ++j) { const f32x4 gv = *(const f32x4*)(gain + 256 * j + 4 * lane), sh = *(const f32x4*)(mb + 256 * j + 4 * lane), sc = *(const f32x4*)(mb + 1024 + 256 * j + 4 * lane);
                const f32x4 o = v[j] * rstd * gv * (sc + 1.0f) + sh;
                v2u w; w.x = pk2(o[0], o[1]); w.y = pk2(o[2], o[3]);
                *(v2u*)(HB + (size_t)m * 1024 + 256 * j + 4 * lane) = w;
                if (router) {
#pragma unroll
                    for (int i = 0; i < 4; ++i)
#pragma unroll
                        for (int e = 0; e < 8; ++e) lg[e] += o[i] * rw[j][i][e];
                }
            }
            if (router) {
                {
                    float a4[4], a2[2], a1;
                    { const bool hi = (lane & 1) != 0;
#pragma unroll
                      for (int e = 0; e < 4; ++e) { const float snd = hi ? lg[e] : lg[e + 4], keep = hi ? lg[e + 4] : lg[e]; a4[e] = keep + __shfl_xor(snd, 1); } }
                    { const bool hi = (lane & 2) != 0;
#pragma unroll
                      for (int e = 0; e < 2; ++e) { const float snd = hi ? a4[e] : a4[e + 2], keep = hi ? a4[e + 2] : a4[e]; a2[e] = keep + __shfl_xor(snd, 2); } }
                    { const bool hi = (lane & 4) != 0; const float snd = hi ? a2[0] : a2[1], keep = hi ? a2[1] : a2[0]; a1 = keep + __shfl_xor(snd, 4); }
                    a1 += __shfl_xor(a1, 8); a1 += __shfl_xor(a1, 16); a1 += __shfl_xor(a1, 32);
#pragma unroll
                    for (int e = 0; e < 8; ++e) lg[e] = __builtin_bit_cast(float, __builtin_amdgcn_readlane(__builtin_bit_cast(int, a1), ((e >> 2) & 1) | (((e >> 1) & 1) << 1) | ((e & 1) << 2)));
                }
                int e0 = 0; float v0 = lg[0];
#pragma unroll
                for (int e = 1; e < 8; ++e) if (lg[e] > v0) { v0 = lg[e]; e0 = e; }
                int e1 = -1; float v1 = -3.0e38f;
#pragma unroll
                for (int e = 0; e < 8; ++e) if (e != e0 && lg[e] > v1) { v1 = lg[e]; e1 = e; }
                const float g0 = 1.0f / (1.0f + __expf(v1 - v0));
                if (lane == 0) { route_e_w[m] = e0 | (e1 << 8); route_g_w[m] = (f32x2){g0, 1.0f - g0}; __hip_atomic_fetch_add(&lcnt[e0], 1, __ATOMIC_RELAXED, __HIP_MEMORY_SCOPE_WORKGROUP); __hip_atomic_fetch_add(&lcnt[e1], 1, __ATOMIC_RELAXED, __HIP_MEMORY_SCOPE_WORKGROUP);
                    gu32* bc_ = F.ctl + CW_BCNT + ((l >> 1) * 256 + m / (M / F.G)) * 8; (void)__hip_atomic_fetch_add(bc_ + e0, 1u, RLX_AGENT); (void)__hip_atomic_fetch_add(bc_ + e1, 1u, RLX_AGENT); }
            }
        }
    }
#undef NORM_PREFETCH
    if (router) {
        __syncthreads();
        if (F.tid < 8) atomicAdd((unsigned*)F.ctl + CW_CNT + (l >> 1) * 16 + F.tid, (unsigned)lcnt[F.tid]);
    }
    (void)route_e;
}

__device__ __forceinline__ int carry_cr(int dir, int b, int k) {
    if (dir == 0) return k < 8 ? 1024 + b * 8 + k : b * 128 + (k - 8);
    return k < 8 ? 1024 + b * 8 + (7 - k) : b * 128 + 127 - (k - 8);
}
__device__ __forceinline__ void carry_phase(Ctx& F, int l) {
    F.tid = lt_tid(); F.lane = F.tid & 63;
    LAS float* EX = (LAS float*)F.lds;
    for (int it = F.vcu; it < 256; it += F.G) {
        const int b = it >> 5, g = it & 31;
        const int p = F.tid & 63, dir = (F.tid >> 6) & 1, seg = F.tid >> 7;
        const int pi = ((l * 2 + dir) * 32 + g) * 64 + p;
        const float are = fminf(F.in[I_ARE][pi], -1e-4f), aim = F.in[I_AIM][pi];
        const float dt = __expf(F.in[I_LOGSTEP][(l * 2 + dir) * 32 + g]);
        float s32, c32; sincos_red(aim * dt * 32.0f, s32, c32); const float m32 = __expf(are * dt * 32.0f);
        const float Lr = m32 * c32, Li = m32 * s32;
        const float* S = (const float*)(F.ws + WS_S) + (size_t)g * NCRP * 256 + dir * 128 + p;
        bf16* AY = (bf16*)(F.ws + WS_AY) + (size_t)g * NCRP * KY + 512 + dir * 128 + p;
        float sr[34], si[34];
#pragma unroll
        for (int i = 0; i < 34; ++i) { const int cr = carry_cr(dir, b, seg * 34 + i); sr[i] = S[(size_t)cr * 256]; si[i] = S[(size_t)cr * 256 + 64]; }
        float hr = 0.f, hi = 0.f, pr = 1.f, pim = 0.f;
#pragma unroll
        for (int i = 0; i < 34; ++i) { const float nr = Lr * hr - Li * hi + sr[i], ni = Lr * hi + Li * hr + si[i]; hr = nr; hi = ni; const float qr = pr * Lr - pim * Li, qi = pr * Li + pim * Lr; pr = qr; pim = qi; }
        __syncthreads();
        EX[(seg * 128 + (F.tid & 127)) * 2] = hr; EX[(seg * 128 + (F.tid & 127)) * 2 + 1] = hi;
        __syncthreads();
        float h0r = 0.f, h0i = 0.f;
        for (int j = 0; j < seg; ++j) { const float er = EX[(j * 128 + (F.tid & 127)) * 2], ei = EX[(j * 128 + (F.tid & 127)) * 2 + 1];
            const float nr = pr * h0r - pim * h0i + er, ni = pr * h0i + pim * h0r + ei; h0r = nr; h0i = ni; }
        hr = h0r; hi = h0i;
#pragma unroll
        for (int i = 0; i < 34; ++i) { const int cr = carry_cr(dir, b, seg * 34 + i);
            AY[(size_t)cr * KY] = (bf16)f2bf(hr); AY[(size_t)cr * KY + 64] = (bf16)f2bf(hi);
            const float nr = Lr * hr - Li * hi + sr[i], ni = Lr * hi + Li * hr + si[i]; hr = nr; hi = ni; }
    }
}

constexpr int SI_HP = 528, SI_AP = 272, SI_H_OFF = 0, SI_A_OFF = 144 * SI_HP, SI_EX_OFF = SI_A_OFF + 144 * SI_AP;
static_assert(SI_EX_OFF + 4 * 128 * 8 <= LDSCTL_OFF, "ssm item LDS map");
__device__ __forceinline__ int si_cr(int b, int r) { return r < 8 ? 1024 + 8 * b + r : 128 * b + r - 8; }
__device__ __forceinline__ void ssm_item(Ctx& F, int l, int b, int g, bool last) {
    F.tid = lt_tid(); F.lane = F.tid & 63;
    const int tid = F.tid, w = lt_s(F.wave), lane = F.lane, fr = lane & 15, fq = lane >> 4;
    LAS unsigned char* Hb = F.lds + SI_H_OFF; LAS unsigned char* Ab = F.lds + SI_A_OFF; LAS float* EX = (LAS float*)(F.lds + SI_EX_OFF);
    const bf16* AY = (const bf16*)(F.ws + WS_AY) + (size_t)g * NCRP * KY;
    const bf16* BtS = (const bf16*)(F.ws + WS_BTS) + (size_t)g * 256 * 512;
    const bf16* BtY = (const bf16*)(F.ws + WS_BTY) + (size_t)g * 512 * KY;
    __syncthreads();
    for (int i = tid; i < 8 * SI_AP / 4; i += 512) ((LAS unsigned*)(Ab + 136 * SI_AP))[i] = 0u;
#define SI_PREF(kc) do { _Pragma("unroll") for (int ps = 0; ps < 5; ++ps) { const int row = ps * 32 + (tid >> 4); if (row < 136) \
        pre[ps] = *(const v4u*)(AY + (size_t)si_cr(b, row) * KY + (kc) * 128 + (tid & 15) * 8); } } while (0)
#define SI_COMMIT() do { _Pragma("unroll") for (int ps = 0; ps < 5; ++ps) { const int row = ps * 32 + (tid >> 4); if (row < 136) \
        *(LAS v4u*)(Ab + row * SI_AP + (tid & 15) * 16) = pre[ps]; } } while (0)
#define SI_STAGE(kc) do { _Pragma("unroll") for (int ps = 0; ps < 5; ++ps) { const int row = ps * 32 + (tid >> 4); if (row < 136) \
        *(LAS v4u*)(Ab + row * SI_AP + (tid & 15) * 16) = *(const v4u*)(AY + (size_t)si_cr(b, row) * KY + (kc) * 128 + (tid & 15) * 8); } } while (0)
    v4u pre[5];
#pragma unroll
    for (int ps = 0; ps < 5; ++ps) pre[ps] = (v4u){0u, 0u, 0u, 0u};
    {
        f32x4 acc[2][9];
#pragma unroll
        for (int t = 0; t < 2; ++t)
#pragma unroll
            for (int mt = 0; mt < 9; ++mt) acc[t][mt] = (f32x4){0.f, 0.f, 0.f, 0.f};
        const bf16* bp = BtS + (size_t)(32 * w + fr) * 512 + 8 * fq;
        bf16x8 bw[2][4][2];
#pragma unroll
        for (int k4 = 0; k4 < 4; ++k4)
#pragma unroll
            for (int t = 0; t < 2; ++t) bw[0][k4][t] = *(const bf16x8*)(bp + (size_t)(16 * t) * 512 + 32 * k4);
        SI_PREF(0);
#pragma unroll
        for (int kc = 0; kc < 4; ++kc) {
            SI_COMMIT();
            __syncthreads();
            if (kc + 1 < 4) SI_PREF(kc + 1); else SI_PREF(0);
            if (kc + 1 < 4) {
#pragma unroll
                for (int k4 = 0; k4 < 4; ++k4)
#pragma unroll
                    for (int t = 0; t < 2; ++t) bw[(kc + 1) & 1][k4][t] = *(const bf16x8*)(bp + (size_t)(16 * t) * 512 + 32 * (4 * (kc + 1) + k4));
            }
#pragma unroll
            for (int k4 = 0; k4 < 4; ++k4) {
#pragma unroll
                for (int mt = 0; mt < 9; ++mt) { const bf16x8 af = *(const LAS bf16x8*)(Ab + (16 * mt + fr) * SI_AP + (32 * k4 + 8 * fq) * 2);
#pragma unroll
                    for (int t = 0; t < 2; ++t) acc[t][mt] = __builtin_amdgcn_mfma_f32_16x16x32_bf16(bw[kc & 1][k4][t], af, acc[t][mt], 0, 0, 0); }
            }
            __syncthreads();
        }
#pragma unroll
        for (int t = 0; t < 2; ++t)
#pragma unroll
            for (int mt = 0; mt < 9; ++mt) { v2u o; o.x = cvt_pk_bf16(acc[t][mt][0], acc[t][mt][1]); o.y = cvt_pk_bf16(acc[t][mt][2], acc[t][mt][3]);
                *(LAS v2u*)(Hb + (16 * mt + fr) * SI_HP + (32 * w + 16 * t + 4 * fq) * 2) = o; }
    }
    __syncthreads();
    {
        const int p = tid & 63, dir = (tid >> 6) & 1, seg = tid >> 7;
        const int pi = ((l * 2 + dir) * 32 + g) * 64 + p;
        const float are = fminf(F.in[I_ARE][pi], -1e-4f), aim = F.in[I_AIM][pi];
        const float dt = __expf(F.in[I_LOGSTEP][(l * 2 + dir) * 32 + g]);
        float s32, c32; sincos_red(aim * dt * 32.0f, s32, c32); const float m32 = __expf(are * dt * 32.0f);
        const float Lr = m32 * c32, Li = m32 * s32;
        LAS unsigned short* col = (LAS unsigned short*)(Hb + (dir * 128 + p) * 2);
        float sr[34], si[34];
#pragma unroll
        for (int i = 0; i < 34; ++i) { const int k = seg * 34 + i; const int r = dir ? (k < 8 ? 7 - k : 143 - k) : k;
            sr[i] = bf2f(col[r * (SI_HP / 2)]); si[i] = bf2f(col[r * (SI_HP / 2) + 64]); }
        float hr = 0.f, hi = 0.f, pr = 1.f, pim = 0.f;
#pragma unroll
        for (int i = 0; i < 34; ++i) { const float nr = Lr * hr - Li * hi + sr[i], ni = Lr * hi + Li * hr + si[i]; hr = nr; hi = ni; const float qr = pr * Lr - pim * Li, qi = pr * Li + pim * Lr; pr = qr; pim = qi; }
        EX[(seg * 128 + (tid & 127)) * 2] = hr; EX[(seg * 128 + (tid & 127)) * 2 + 1] = hi;
        __syncthreads();
        float h0r = 0.f, h0i = 0.f;
        for (int j = 0; j < seg; ++j) { const float er = EX[(j * 128 + (tid & 127)) * 2], ei = EX[(j * 128 + (tid & 127)) * 2 + 1];
            const float nr = pr * h0r - pim * h0i + er, ni = pr * h0i + pim * h0r + ei; h0r = nr; h0i = ni; }
        hr = h0r; hi = h0i;
#pragma unroll
        for (int i = 0; i < 34; ++i) { const int k = seg * 34 + i; const int r = dir ? (k < 8 ? 7 - k : 143 - k) : k;
            col[r * (SI_HP / 2)] = (unsigned short)f2bf(hr); col[r * (SI_HP / 2) + 64] = (unsigned short)f2bf(hi);
            const float nr = Lr * hr - Li * hi + sr[i], ni = Lr * hi + Li * hr + si[i]; hr = nr; hi = ni; }
    }
    __syncthreads();
    for (int hp = 0; hp < 2; ++hp) {
        f32x4 acc[2][9];
#pragma unroll
        for (int t = 0; t < 2; ++t)
#pragma unroll
            for (int mt = 0; mt < 9; ++mt) acc[t][mt] = (f32x4){0.f, 0.f, 0.f, 0.f};
        const bf16* bp = BtY + (size_t)(64 * w + 32 * hp + fr) * KY + 8 * fq;
        bf16x8 bw[2][4][2];
#pragma unroll
        for (int k4 = 0; k4 < 4; ++k4)
#pragma unroll
            for (int t = 0; t < 2; ++t) bw[0][k4][t] = *(const bf16x8*)(bp + (size_t)(16 * t) * KY + 32 * k4);
#pragma unroll
        for (int kc = 0; kc < 6; ++kc) {
            if (kc < 4) { SI_COMMIT(); __syncthreads(); if (kc + 1 < 4) SI_PREF(kc + 1); }
            if (kc == 4 && hp == 0) SI_PREF(0);
            if (kc + 1 < 6) {
#pragma unroll
                for (int k4 = 0; k4 < 4; ++k4)
#pragma unroll
                    for (int t = 0; t < 2; ++t) bw[(kc + 1) & 1][k4][t] = *(const bf16x8*)(bp + (size_t)(16 * t) * KY + 32 * (4 * (kc + 1) + k4));
            }
            const LAS unsigned char* abase = kc < 4 ? (const LAS unsigned char*)Ab : (const LAS unsigned char*)(Hb + (kc - 4) * 256);
            const int apitch = kc < 4 ? SI_AP : SI_HP;
#pragma unroll
            for (int k4 = 0; k4 < 4; ++k4) {
#pragma unroll
                for (int mt = 0; mt < 9; ++mt) { const bf16x8 af = *(const LAS bf16x8*)(abase + (16 * mt + fr) * apitch + (32 * k4 + 8 * fq) * 2);
#pragma unroll
                    for (int t = 0; t < 2; ++t) acc[t][mt] = __builtin_amdgcn_mfma_f32_16x16x32_bf16(bw[kc & 1][k4][t], af, acc[t][mt], 0, 0, 0); }
            }
            if (kc < 4) __syncthreads();
        }
        bf16* G = (bf16*)(F.ws + WS_G);
#pragma unroll
        for (int mt = 0; mt < 9; ++mt) { const int r = 16 * mt + fr;
            if (r < 136 && !(last && r < 8)) {
                const size_t tok0 = (size_t)si_cr(b, r) * 32;
#pragma unroll
                for (int t = 0; t < 2; ++t) { v2u o; o.x = cvt_pk_bf16(gelu_tanh(acc[t][mt][0]), gelu_tanh(acc[t][mt][1])); o.y = cvt_pk_bf16(gelu_tanh(acc[t][mt][2]), gelu_tanh(acc[t][mt][3]));
                    *(v2u*)(G + (tok0 + 4 * w + 2 * hp + t) * 512 + g * 16 + 4 * fq) = o; }
            }
        }
    }
#undef SI_STAGE
#undef SI_PREF
#undef SI_COMMIT
    __syncthreads();
}

constexpr int KS_STRIDE = 144, VT_STRIDE = 144, KS_SLOT = 64 * KS_STRIDE, VT_SLOT = 64 * VT_STRIDE;
typedef short v4i16_t __attribute__((ext_vector_type(4)));
template <int NKB, bool LAT>
__device__ __forceinline__ void attn_tile(const LAS unsigned char* Ks, const LAS unsigned char* Vt, int kbase, const bf16x8 (&qf)[2], f32x4 (&O)[4], float& mrun, float& lrun,
                                          int fr, int fq, const LAS float* biasrow, int qc, int cs) {
    f32x4 st[2 * NKB];
#pragma unroll
    for (int kt = 0; kt < 2 * NKB; ++kt) {
        st[kt] = (f32x4){0.f, 0.f, 0.f, 0.f};
#pragma unroll
        for (int ks = 0; ks < 2; ++ks) { const bf16x8 kf = *(const LAS bf16x8*)(Ks + (kbase + 16 * kt + fr) * KS_STRIDE + (8 * fq + 32 * ks) * 2);
            st[kt] = __builtin_amdgcn_mfma_f32_16x16x32_bf16(kf, qf[ks], st[kt], 0, 0, 0); }
    }
    float tmax = -3.0e38f;
#pragma unroll
    for (int kt = 0; kt < 2 * NKB; ++kt)
#pragma unroll
        for (int i = 0; i < 4; ++i) {
            if (LAT) { const int kc = kbase + 16 * kt + 4 * fq + i; const bool ok = (kc >= cs) && (kc < cs + 16);
                const float bv = biasrow[ok ? (kc - qc + 15) : 0];
                st[kt][i] = ok ? st[kt][i] + bv : -__builtin_inff(); }
            tmax = fmaxf(tmax, st[kt][i]);
        }
    tmax = fmaxf(tmax, __shfl_xor(tmax, 16)); tmax = fmaxf(tmax, __shfl_xor(tmax, 32));
    const float mnew = fmaxf(mrun, tmax), alpha = __builtin_amdgcn_exp2f(mrun - mnew);
    float ps = 0.f;
#pragma unroll
    for (int kt = 0; kt < 2 * NKB; ++kt)
#pragma unroll
        for (int i = 0; i < 4; ++i) { const float pv = __builtin_amdgcn_exp2f(st[kt][i] - mnew); st[kt][i] = pv; ps += pv; }
    lrun = lrun * alpha + ps; mrun = mnew;
#pragma unroll
    for (int dt = 0; dt < 4; ++dt) O[dt] = O[dt] * alpha;
#pragma unroll
    for (int kb = 0; kb < NKB; ++kb) {
        union { bf16x8 v; unsigned u[4]; } pf;
        pf.u[0] = cvt_pk_bf16(st[2 * kb][0], st[2 * kb][1]); pf.u[1] = cvt_pk_bf16(st[2 * kb][2], st[2 * kb][3]);
        pf.u[2] = cvt_pk_bf16(st[2 * kb + 1][0], st[2 * kb + 1][1]); pf.u[3] = cvt_pk_bf16(st[2 * kb + 1][2], st[2 * kb + 1][3]);
#pragma unroll
        for (int dt = 0; dt < 4; ++dt) {
            union { bf16x8 v; v4i16_t t[2]; } vf;
            const LAS unsigned char* vp = Vt + (kbase + 32 * kb + 4 * fq + (fr >> 2)) * VT_STRIDE + (16 * dt + 4 * (fr & 3)) * 2;
            vf.t[0] = __builtin_amdgcn_ds_read_tr16_b64_v4i16((LAS v4i16_t*)vp); vf.t[1] = __builtin_amdgcn_ds_read_tr16_b64_v4i16((LAS v4i16_t*)(vp + 16 * VT_STRIDE));
            O[dt] = __builtin_amdgcn_mfma_f32_16x16x32_bf16(vf.v, pf.v, O[dt], 0, 0, 0);
        }
    }
}
__device__ __forceinline__ float xl_max4(float x) {
    unsigned u = __builtin_bit_cast(unsigned, x); auto a = __builtin_amdgcn_permlane16_swap(u, u, false, false);
    const float m = fmaxf(__builtin_bit_cast(float, a[0]), __builtin_bit_cast(float, a[1]));
    u = __builtin_bit_cast(unsigned, m); auto b = __builtin_amdgcn_permlane32_swap(u, u, false, false);
    return fmaxf(__builtin_bit_cast(float, b[0]), __builtin_bit_cast(float, b[1]));
}
template <bool LAT>
__device__ __forceinline__ void attn_stage(const LAS unsigned char* stg, int cnt, int tile_b, const bf16x8 (&qf)[2], f32x4 (&O)[4], float& mrun, float& lrun,
                                           int fr, int fq, int kbase, const LAS float* bias_s, int kr0, int my_rs, int qrow, int qc, int cs) {
    constexpr int NKT = LAT ? 2 : 4, NKB = NKT / 2;
    f32x4 st[4][NKT];
#pragma unroll
    for (int j = 0; j < 4; ++j) {
        const bool rv = LAT ? (j < cnt && (kr0 + j) >= my_rs && (kr0 + j) < my_rs + 8) : true;
        if (rv) {
            const LAS unsigned char* Ks = stg + j * tile_b;
#pragma unroll
            for (int kt = 0; kt < NKT; ++kt) {
                st[j][kt] = (f32x4){0.f, 0.f, 0.f, 0.f};
#pragma unroll
                for (int ks = 0; ks < 2; ++ks) { const bf16x8 kf = *(const LAS bf16x8*)(Ks + (kbase + 16 * kt + fr) * KS_STRIDE + (8 * fq + 32 * ks) * 2);
                    st[j][kt] = __builtin_amdgcn_mfma_f32_16x16x32_bf16(kf, qf[ks], st[j][kt], 0, 0, 0); }
            }
        } else {
#pragma unroll
            for (int kt = 0; kt < NKT; ++kt) st[j][kt] = (f32x4){0.f, 0.f, 0.f, 0.f};
        }
    }
    float tmax = -3.0e38f;
    if (LAT) {
        float bv[4][NKT][4];
#pragma unroll
        for (int j = 0; j < 4; ++j) { const int rrel = min(max(kr0 + j - qrow + 7, 0), 14);
#pragma unroll
            for (int kt = 0; kt < NKT; ++kt)
#pragma unroll
                for (int i = 0; i < 4; ++i) { const int kc = kbase + 16 * kt + 4 * fq + i; bv[j][kt][i] = bias_s[rrel * 31 + min(max(kc - qc + 15, 0), 30)]; } }
#pragma unroll
        for (int j = 0; j < 4; ++j) { const bool rv = (j < cnt && (kr0 + j) >= my_rs && (kr0 + j) < my_rs + 8);
#pragma unroll
            for (int kt = 0; kt < NKT; ++kt)
#pragma unroll
                for (int i = 0; i < 4; ++i) { const int kc = kbase + 16 * kt + 4 * fq + i; const bool ok = rv && (kc >= cs) && (kc < cs + 16);
                    st[j][kt][i] = ok ? st[j][kt][i] + bv[j][kt][i] : -__builtin_inff(); tmax = fmaxf(tmax, st[j][kt][i]); } }
    } else {
#pragma unroll
        for (int j = 0; j < 4; ++j)
#pragma unroll
            for (int kt = 0; kt < NKT; ++kt)
#pragma unroll
                for (int i = 0; i < 4; ++i) tmax = fmaxf(tmax, st[j][kt][i]);
    }
    tmax = xl_max4(tmax);
    const float mnew = fmaxf(mrun, tmax), alpha = __builtin_amdgcn_exp2f(mrun - mnew);
    float ps = 0.f;
#pragma unroll
    for (int j = 0; j < 4; ++j)
#pragma unroll
        for (int kt = 0; kt < NKT; ++kt)
#pragma unroll
            for (int i = 0; i < 4; ++i) { const float pv = __builtin_amdgcn_exp2f(st[j][kt][i] - mnew); st[j][kt][i] = pv; ps += pv; }
    lrun = lrun * alpha + ps; mrun = mnew;
#pragma unroll
    for (int dt = 0; dt < 4; ++dt) O[dt] = O[dt] * alpha;
#pragma unroll
    for (int j = 0; j < 4; ++j) {
        const bool rv = LAT ? (j < cnt && (kr0 + j) >= my_rs && (kr0 + j) < my_rs + 8) : true;
        if (rv) {
            const LAS unsigned char* Vt = stg + j * tile_b + KS_SLOT;
#pragma unroll
            for (int kb = 0; kb < NKB; ++kb) {
                union { bf16x8 v; unsigned u[4]; } pf;
                pf.u[0] = cvt_pk_bf16(st[j][2 * kb][0], st[j][2 * kb][1]); pf.u[1] = cvt_pk_bf16(st[j][2 * kb][2], st[j][2 * kb][3]);
                pf.u[2] = cvt_pk_bf16(st[j][2 * kb + 1][0], st[j][2 * kb + 1][1]); pf.u[3] = cvt_pk_bf16(st[j][2 * kb + 1][2], st[j][2 * kb + 1][3]);
#pragma unroll
                for (int dt = 0; dt < 4; ++dt) {
                    union { bf16x8 v; v4i16_t t[2]; } vf;
                    const LAS unsigned char* vp = Vt + (kbase + 32 * kb + 4 * fq + (fr >> 2)) * VT_STRIDE + (16 * dt + 4 * (fr & 3)) * 2;
                    vf.t[0] = __builtin_amdgcn_ds_read_tr16_b64_v4i16((LAS v4i16_t*)vp); vf.t[1] = __builtin_amdgcn_ds_read_tr16_b64_v4i16((LAS v4i16_t*)(vp + 16 * VT_STRIDE));
                    O[dt] = __builtin_amdgcn_mfma_f32_16x16x32_bf16(vf.v, pf.v, O[dt], 0, 0, 0);
                }
            }
        }
    }
}
constexpr int ATT_TG = 4, ATT_TILE_B = KS_SLOT + VT_SLOT, ATT_STAGE_B = ATT_TG * ATT_TILE_B, ATT_BIAS2_OFF = LDSCTL_OFF + 1024, ATT_BIAS_B = 1920;
static_assert(2 * ATT_STAGE_B <= LDSCTL_OFF && ATT_BIAS2_OFF + 2 * ATT_BIAS_B <= LDS_BYTES, "attention LDS map");
struct AttItem { int b, h, rp, rsA, rsB, ntile, nstage; };
__device__ __forceinline__ AttItem att_dec(int it) { AttItem a; a.b = it >> 8; a.h = (it >> 5) & 7; a.rp = it & 31; a.rsA = min(max(2 * a.rp - 4, 0), 56); a.rsB = min(max(2 * a.rp - 3, 0), 56);
    a.ntile = a.rsB + 8 - a.rsA + 4; a.nstage = (a.ntile + ATT_TG - 1) / ATT_TG; return a; }
__device__ __forceinline__ void attn_phase(Ctx& F, int l, bool do_ctx, int it0, int nit, int stride) {
    F.tid = lt_tid(); F.lane = F.tid & 63;
    LAS unsigned char* lds = F.lds;
    const bf16* Qb = (const bf16*)(F.ws + WS_Q); const bf16* Kb = (const bf16*)(F.ws + WS_K); const bf16* Vb = (const bf16*)(F.ws + WS_V);
    bf16* YA = (bf16*)(F.ws + WS_YA);
    const int tid = F.tid, w = lt_s(F.wave), lane = F.lane, fr = lane & 15, fq = lane >> 4;
    const int lkey = tid >> 3, lch = tid & 7, ct = w & 3, qc = 16 * ct + fr;
    const int wsc = min(max(16 * ct - 8, 0), 32), cs = min(max(qc - 8, 0), 48);
    const float* rpb = F.in[I_RPB] + (size_t)l * 8 * 465;
    {
        int lit = it0, lst = 0, lpar = 0, lrem = nit; bool lvalid = lrem > 0; AttItem LI = att_dec(lvalid ? lit : 0);
        int cit = it0, cst = 0, cpar = 0, crem = nit; AttItem CI = att_dec(crem > 0 ? cit : 0);
        v4u k0r[ATT_TG], v0r[ATT_TG], k1r[ATT_TG], v1r[ATT_TG]; float bias0 = 0.f, bias1 = 0.f; int cnt0 = 0, cnt1 = 0, fst0 = 0, fst1 = 0;
        bf16x8 qn[2], qf[2]; f32x4 O[4]; float mrun = -1.0e30f, lrun = 0.f; int qrow = 0, my_rs = 0, tokq = 0;
        qn[0] = (bf16x8){0,0,0,0,0,0,0,0}; qn[1] = qn[0]; qf[0] = qn[0]; qf[1] = qn[0];
#pragma unroll
        for (int dt = 0; dt < 4; ++dt) O[dt] = (f32x4){0.f, 0.f, 0.f, 0.f};
#define ATT_LD(KR, VR, BIASR, CNT, FST) do { CNT = 0; FST = 0; if (lvalid) { CNT = min(ATT_TG, LI.ntile - ATT_TG * lst); FST = (lst == 0) ? (1 + lpar) : 0; \
            const size_t hoff = (size_t)LI.h * 64 + 8 * lch; \
            _Pragma("unroll") for (int j = 0; j < ATT_TG; ++j) if (j < CNT) { const int t = lst * ATT_TG + j; \
                const int tokk = (t < 4 ? MLAT + LI.b * 256 + 64 * t : LI.b * 4096 + (LI.rsA + t - 4) * 64) + lkey; \
                KR[j] = *(const v4u*)(Kb + (size_t)tokk * 512 + hoff); VR[j] = *(const v4u*)(Vb + (size_t)tokk * 512 + hoff); } \
            if (lst == 0) { BIASR = tid < 465 ? rpb[LI.h * 465 + tid] * LOG2E : 0.f; \
                const int tq = LI.b * 4096 + (2 * LI.rp + (w >> 2)) * 64 + qc; \
                qn[0] = *(const bf16x8*)(Qb + (size_t)tq * 512 + LI.h * 64 + 8 * fq); qn[1] = *(const bf16x8*)(Qb + (size_t)tq * 512 + LI.h * 64 + 32 + 8 * fq); } \
            ++lst; if (lst == LI.nstage) { lit += stride; --lrem; lvalid = lrem > 0; if (lvalid) LI = att_dec(lit); lst = 0; lpar ^= 1; } } } while (0)
#define ATT_ST(KR, VR, BIASR, CNT, FST, BUF) do { \
            _Pragma("unroll") for (int j = 0; j < ATT_TG; ++j) if (j < CNT) { \
                LAS unsigned char* Ks = lds + (BUF) * ATT_STAGE_B + j * ATT_TILE_B; LAS unsigned char* Vt = Ks + KS_SLOT; \
                *(LAS v4u*)(Ks + lkey * KS_STRIDE + lch * 16) = KR[j]; *(LAS v4u*)(Vt + lkey * VT_STRIDE + lch * 16) = VR[j]; } \
            if (FST && tid < 465) ((LAS float*)(lds + ATT_BIAS2_OFF + (FST - 1) * ATT_BIAS_B))[tid] = BIASR; } while (0)
#define ATT_COMPUTE(BUF) do { \
            if (cst == 0) { qf[0] = qn[0]; qf[1] = qn[1]; mrun = -1.0e30f; lrun = 0.f; _Pragma("unroll") for (int dt = 0; dt < 4; ++dt) O[dt] = (f32x4){0.f, 0.f, 0.f, 0.f}; \
                qrow = 2 * CI.rp + (w >> 2); my_rs = (w >> 2) ? CI.rsB : CI.rsA; tokq = CI.b * 4096 + qrow * 64 + qc; } \
            const LAS float* bias_s = (const LAS float*)(lds + ATT_BIAS2_OFF + cpar * ATT_BIAS_B); \
            if (cst == 0) attn_stage<false>(lds + (BUF) * ATT_STAGE_B, 4, ATT_TILE_B, qf, O, mrun, lrun, fr, fq, 0, bias_s, 0, 0, 0, 0, 0); \
            else attn_stage<true>(lds + (BUF) * ATT_STAGE_B, min(ATT_TG, CI.ntile - ATT_TG * cst), ATT_TILE_B, qf, O, mrun, lrun, fr, fq, wsc, bias_s, CI.rsA + ATT_TG * cst - 4, my_rs, qrow, qc, cs); \
            ++cst; \
            if (cst == CI.nstage) { float ls = lrun; ls += __shfl_xor(ls, 16); ls += __shfl_xor(ls, 32); const float inv = 1.0f / ls; \
                _Pragma("unroll") for (int dt = 0; dt < 4; ++dt) { v2u o; o.x = pk2(O[dt][0] * inv, O[dt][1] * inv); o.y = pk2(O[dt][2] * inv, O[dt][3] * inv); \
                    *(v2u*)(YA + (size_t)tokq * 1024 + 512 + CI.h * 64 + 16 * dt + 4 * fq) = o; } \
                cit += stride; --crem; if (crem > 0) CI = att_dec(cit); cst = 0; cpar ^= 1; } } while (0)
        if (crem > 0) {
            __syncthreads();
            ATT_LD(k0r, v0r, bias0, cnt0, fst0);
            ATT_LD(k1r, v1r, bias1, cnt1, fst1);
            ATT_ST(k0r, v0r, bias0, cnt0, fst0, 0);
            __syncthreads();
            for (;;) {
                ATT_LD(k0r, v0r, bias0, cnt0, fst0);
                ATT_COMPUTE(0);
                if (crem <= 0) break;
                ATT_ST(k1r, v1r, bias1, cnt1, fst1, 1);
                __syncthreads();
                ATT_LD(k1r, v1r, bias1, cnt1, fst1);
                ATT_COMPUTE(1);
                if (crem <= 0) break;
                ATT_ST(k0r, v0r, bias0, cnt0, fst0, 0);
                __syncthreads();
            }
        }
#undef ATT_LD
#undef ATT_ST
#undef ATT_COMPUTE
    }
    if (do_ctx) {
        for (int it = F.vcu; it < 128; it += F.G) {
            const int b = it >> 4, h = (it >> 1) & 7, half = it & 1;
            const int tokq = MLAT + b * 256 + half * 128 + w * 16 + fr;
            const size_t hoff = (size_t)h * 64 + 8 * lch;
            v4u kreg[4], vreg[4];
#pragma unroll
            for (int j = 0; j < 4; ++j) { const int tokk = MLAT + b * 256 + 64 * j + lkey; kreg[j] = *(const v4u*)(Kb + (size_t)tokk * 512 + hoff); vreg[j] = *(const v4u*)(Vb + (size_t)tokk * 512 + hoff); }
            bf16x8 qf[2];
            qf[0] = *(const bf16x8*)(Qb + (size_t)tokq * 512 + h * 64 + 8 * fq); qf[1] = *(const bf16x8*)(Qb + (size_t)tokq * 512 + h * 64 + 32 + 8 * fq);
            __syncthreads();
#pragma unroll
            for (int j = 0; j < 4; ++j) { LAS unsigned char* Ks = lds + j * ATT_TILE_B; LAS unsigned char* Vt = Ks + KS_SLOT;
                *(LAS v4u*)(Ks + lkey * KS_STRIDE + lch * 16) = kreg[j]; *(LAS v4u*)(Vt + lkey * VT_STRIDE + lch * 16) = vreg[j]; }
            __syncthreads();
            f32x4 O[4];
#pragma unroll
            for (int dt = 0; dt < 4; ++dt) O[dt] = (f32x4){0.f, 0.f, 0.f, 0.f};
            float mrun = -1.0e30f, lrun = 0.f;
            attn_stage<false>(lds, 4, ATT_TILE_B, qf, O, mrun, lrun, fr, fq, 0, (const LAS float*)lds, 0, 0, 0, 0, 0);
            lrun += __shfl_xor(lrun, 16); lrun += __shfl_xor(lrun, 32);
            const float inv = 1.0f / lrun;
#pragma unroll
            for (int dt = 0; dt < 4; ++dt) { v2u o; o.x = pk2(O[dt][0] * inv, O[dt][1] * inv); o.y = pk2(O[dt][2] * inv, O[dt][3] * inv);
                *(v2u*)(YA + (size_t)tokq * 1024 + 512 + h * 64 + 16 * dt + 4 * fq) = o; }
        }
    }
}

__device__ __forceinline__ void scatter_phase(Ctx& F, int l, int M, int ncopy) {
    F.tid = lt_tid(); F.lane = F.tid & 63;
    LAS int* lc = (LAS int*)F.lds;
    LAS int* gb = lc + 8; LAS int* lpos = lc + 16;
    const unsigned* cnt = (const unsigned*)F.ctl + CW_CNT + (l >> 1) * 16;
    const int* route_e = (const int*)(F.ws + WS_ROUTE); int* slot_of = (int*)(F.ws + WS_ROUTE + 576 * 1024);
    const bf16* HB = (const bf16*)(F.ws + WS_HB); bf16* XS = (bf16*)(F.ws + WS_XS);
    int segp[9]; moe_seg(cnt, segp);
    const int per = M / F.G;
    const int t0 = F.vcu * per;
    LAS int* ent = lc + 16 + 512;
    if (F.tid < 8) gb[F.tid] = 0;
    __syncthreads();
    const int nent = 2 * per;
    int my_e = 0;
    if (F.tid < nent) { const int tok = t0 + (F.tid >> 1), re = route_e[tok]; my_e = (F.tid & 1) ? (re >> 8) : (re & 255); ent[F.tid] = my_e; }
    if (F.tid < F.vcu && F.tid < 256) { const unsigned* bc = (const unsigned*)F.ctl + CW_BCNT + ((l >> 1) * 256 + F.tid) * 8;
#pragma unroll
        for (int e = 0; e < 8; ++e) { const int c = (int)bc[e]; if (c) __hip_atomic_fetch_add(&gb[e], c, __ATOMIC_RELAXED, __HIP_MEMORY_SCOPE_WORKGROUP); } }
    __syncthreads();
    if (F.tid < nent) { int rank = 0; for (int j = 0; j < F.tid; ++j) rank += (ent[j] == my_e) ? 1 : 0;
        const int slot = segp[my_e] * 256 + gb[my_e] + rank; lpos[F.tid] = slot; slot_of[2 * t0 + F.tid] = slot; }
    __syncthreads();
    for (int rep_ = 0; rep_ < ncopy; ++rep_)
    for (int en = F.wave; en < nent; en += 32) {
        v4u a[4][2]; int sl[4];
#pragma unroll
        for (int q = 0; q < 4; ++q) { const int e2 = en + 8 * q; if (e2 < nent) { const int tok = t0 + (e2 >> 1); sl[q] = lpos[e2];
            const v4u* src = (const v4u*)(HB + (size_t)tok * 1024); a[q][0] = src[F.lane]; a[q][1] = src[F.lane + 64]; } }
#pragma unroll
        for (int q = 0; q < 4; ++q) { const int e2 = en + 8 * q; if (e2 < nent) { v4u* dst = (v4u*)(XS + (size_t)sl[q] * 1024); dst[F.lane] = a[q][0]; dst[F.lane + 64] = a[q][1]; } }
    }
}

constexpr int NPL = 14;
constexpr int NPHASE = 1 + DEPTH * NPL + 1;
__global__ void __launch_bounds__(512, 2) mk_fwd(Args args) {
    extern __shared__ __attribute__((aligned(16))) unsigned char lds_raw[];
    Ctx F;
    F.lds = (LAS unsigned char*)lds_raw; F.ws = args.ws; F.ctl = (gu32*)(args.ws + WS_CTL);
    F.tid = threadIdx.x; F.lane = F.tid & 63; F.wave = __builtin_amdgcn_readfirstlane(F.tid >> 6);
    F.G = gridDim.x; { const int bx = blockIdx.x; F.vcu = (F.G % 8 == 0) ? (bx % 8) * (F.G / 8) + bx / 8 : bx; }
    F.in = args.in; F.out = args.out;
    volatile LAS unsigned* MISC = (volatile LAS unsigned*)(F.lds + MISC_OFF);
    for (int u = F.tid; u < (LDS_BYTES - LDSCTL_OFF) / 4; u += 512) ((LAS unsigned*)(F.lds + LDSCTL_OFF))[u] = 0u;
    __syncthreads();
    XcdBarrier bar; bar.bar = (unsigned*)(F.ctl + CW_BAR); bar.x = 0; bar.st = nullptr;
    if (MK_ONE_LAUNCH) bar = xcd_barrier_post((unsigned*)(F.ctl + CW_BAR), MISC + 8);
    const int lo = args.ph_lo, hi = args.ph_hi;
#ifndef MK_PHASES
#define MK_PHASES 0xFFFFFFFFu
#endif
#define PHEN(j) (((MK_PHASES) >> (j)) & 1u)
#define IN(k) (lo <= (k) && (k) < hi)
#ifndef MK_DUP
#define MK_DUP 0u
#endif
#ifndef MK_DUPN
#define MK_DUPN 2
#endif
#define REPS(j) ((((MK_DUP) >> (j)) & 1u) ? MK_DUPN : 1)
#define REPLOOP(j) for (int rep = 0; rep < REPS(j); ++rep)
#define REPBAR() do { if (rep) xcd_barrier(bar); } while (0)
    const float* const gate_zero = (const float*)(F.ctl + 65536);
#define SEAM_BODY() do { if (MK_CONV_SEAM && cv_target < DEPTH) { const XbTok tk_ = xcd_arrive(bar); \
        volatile LAS int* bc_ = (volatile LAS int*)(F.lds + LDSCTL_OFF + 512); \
        if (lt_tid() == 0) bc_[0] = (tk_.role == 0) ? (int)__hip_atomic_fetch_add(F.ctl + CW_Q + 64 * (cv_target * 8 + (int)(bar.x & 7u)), 1u, RLX_AGENT) : 0x7fffff;     \
        __syncthreads(); \
        { const int t_ = (bc_[0] * 8 + (int)(bar.x & 7u)) * 8 + F.wave; if (t_ < conv_ntiles(cv_target)) conv_tile(F, cv_target, t_, (LAS float*)(F.lds + F.wave * 16640), lt_tid() & 63); } \
        xcd_wait(bar, tk_); } else xcd_barrier(bar); } while (0)
#define SEAM(k) do { if (IN(k) && IN((k) + 1)) SEAM_BODY(); } while (0)
    int cv_target = DEPTH, cv_next = 0, cv_prev_done = 0;
    bf16* const HB = (bf16*)(F.ws + WS_HB); float* const X = (float*)(F.ws + WS_X);
    const float* const mod = (const float*)(F.ws + WS_MOD);

#ifdef MK_XBAR
    if (MK_ONE_LAUNCH) for (int xb = 0; xb < MK_XBAR; ++xb) xcd_barrier(bar);
#endif
    if (IN(0) && PHEN(20)) REPLOOP(20) { REPBAR(); mod_phase(F); }
    SEAM(0);
    for (int l = 0; l < DEPTH; ++l) {
        const int pb = 1 + l * NPL;
        const bool last = (l == DEPTH - 1), moe = (l & 1) != 0;
        cv_target = (MK_ONE_LAUNCH && l + 1 < DEPTH && ((l + 1) & 1)) ? l + 1 : DEPTH; cv_next = 0;
        if (IN(pb + 0) && PHEN(0)) {
            for (int rep = 0; rep < REPS(14); ++rep) { for (int it = F.vcu; it < NG * 8; it += F.G) ssm_prepA(F, l, it >> 3, it & 7); }
            __syncthreads();
            if (MK_CONV_SEAM && MK_ONE_LAUNCH && (l & 1)) wconv_drain(F, l, bar.x); else
            for (int rep = 0; rep < REPS(15); ++rep) wconv_phase(F, l, 0);
            for (int rep = 0; rep < REPS(16); ++rep) norm_phase<0>(F, l, MTOT, l == 0 && rep == 0, l > 0 && ((l - 1) & 1) && rep == 0, false, ((l & 1) && rep == 0 && MK_SPLIT_FFN2 > 1) ? mod + ((size_t)(l - 1) * 9 + 8) * 6144 + 5 * 1024 : nullptr, MK_SPLIT_FFN2);
        }
        SEAM(pb + 0);
        if (IN(pb + 1) && PHEN(1)) REPLOOP(1) { REPBAR();
            pg8::Gemm g{HB, (const bf16*)(F.ws + ws_win(l)), 1024, 1024, 1024};
            pg8::TileOrder S; S.init(MTOT / 256, INW / 256, F.G, (int)blockIdx.x, (size_t)256 * 1024 * 2, (size_t)256 * 1024 * 2, 0); S.wgm = MK_WGM_INP;
            EpiInProj E{(bf16*)(F.ws + WS_AY), (bf16*)(F.ws + WS_Q), (bf16*)(F.ws + WS_K), (bf16*)(F.ws + WS_V)};
            pg8::gemm_phase(F.lds, g, S, E);
            if (MK_SSM_FUSED && rep == 0 && !MK_DIAG_PREPB) { for (int it = F.vcu; it < NG * 8; it += F.G) ssm_prepB(F, l, it >> 3, it & 7); }
        }
        SEAM(pb + 1);
#if MK_SSM_FUSED
        if (IN(pb + 2) && (PHEN(2) || PHEN(5))) {
            if (MK_DIAG_PREPB) { for (int it = F.vcu; it < NG * 8; it += F.G) ssm_prepB(F, l, it >> 3, it & 7); xcd_barrier(bar); }
            if (PHEN(5)) for (int rep = 0; rep < REPS(5); ++rep) { if (rep) xcd_barrier(bar); __syncthreads(); attn_phase(F, l, !last, F.vcu, (2048 - F.vcu + F.G - 1) / F.G, F.G); }
            if (PHEN(2)) for (int rep = 0; rep < REPS(2); ++rep) { if (rep) xcd_barrier(bar); for (int it = F.vcu; it < 256; it += F.G) ssm_item(F, l, it >> 5, it & 31, last); }
        }
        SEAM(pb + 2);
#else
        if (IN(pb + 2) && PHEN(2)) REPLOOP(2) { REPBAR();
            pg8::Gemm g{(const bf16*)(F.ws + WS_AY), (const bf16*)(F.ws + WS_BTS), 512, KY, 512};
            pg8::TileOrder S; S.init(NG * 5, 1, F.G, (int)blockIdx.x, (size_t)256 * KY * 2, (size_t)256 * 512 * 2, 5); S.wgm = MK_WGM_SSM;
            EpiS E{(float*)(F.ws + WS_S)};
            pg8::gemm_phase(F.lds, g, S, E);
            if (MK_ATT_SPREAD && rep == 0 && (int)blockIdx.x >= 160) { __syncthreads(); attn_phase(F, l, false, (int)blockIdx.x - 160, 1, 1); }
        }
        SEAM(pb + 2);
        if (IN(pb + 3) && PHEN(3)) REPLOOP(3) { REPBAR(); carry_phase(F, l); for (int it = F.vcu; it < NG * 8; it += F.G) ssm_prepB(F, l, it >> 3, it & 7); }
        if (IN(pb + 3) && PHEN(5)) REPLOOP(5) { if (rep) xcd_barrier(bar); __syncthreads();
            const int a0 = MK_ATT_SPREAD ? 480 + F.vcu : F.vcu; attn_phase(F, l, !last, a0, (2048 - a0 + F.G - 1) / F.G, F.G); }
        SEAM(pb + 3);
        if (IN(pb + 4) && PHEN(4)) REPLOOP(4) { REPBAR();
            pg8::Gemm g{(const bf16*)(F.ws + WS_AY), (const bf16*)(F.ws + WS_BTY), KY, KY, KY};
            pg8::TileOrder S; S.init(NG * 5, 2, F.G, (int)blockIdx.x, (size_t)256 * KY * 2, (size_t)256 * KY * 2, 5);
            if (last) { S.init(NG * 4, 2, F.G, (int)blockIdx.x, (size_t)256 * KY * 2, (size_t)256 * KY * 2, 5); S.skip5 = 1; }
            S.wgm = MK_WGM_SSM;
            EpiY E{(bf16*)(F.ws + WS_G)};
            pg8::gemm_phase(F.lds, g, S, E);
            if (MK_ATT_SPREAD && rep == 0 && (int)blockIdx.x >= 64) { __syncthreads(); attn_phase(F, l, false, 96 + ((int)blockIdx.x - 64) * 2, 2, 1); }
        }
        SEAM(pb + 4);
#endif
        if (IN(pb + 6) && PHEN(6)) REPLOOP(6) { REPBAR();
            pg8::Gemm g{(const bf16*)(F.ws + WS_G), (const bf16*)(F.ws + ws_wglu(l)), 512, 512, 512};
            pg8::TileOrder S; S.init((last ? MLAT : MTOT) / 256, 2, F.G, (int)blockIdx.x, (size_t)256 * 512 * 2, (size_t)256 * 512 * 2, 0);
            S.wgm = MK_WGM_GLU;
            EpiGlu E{(const bf16*)(F.ws + WS_G), F.in[I_GLUB] + l * 512, (bf16*)(F.ws + WS_YA)};
            pg8::gemm_phase(F.lds, g, S, E);
        }
        SEAM(pb + 6);
        if (IN(pb + 7) && PHEN(7)) REPLOOP(7) { REPBAR();
            pg8::Gemm g{(const bf16*)(F.ws + WS_YA), (const bf16*)(F.ws + ws_wout(l)), 1024, 1024, 1024};
            pg8::TileOrder S; S.init((last ? MLAT : MTOT) / 256, 4, F.G, (int)blockIdx.x, (size_t)256 * 1024 * 2, (size_t)256 * 1024 * 2, 0); if (!last && MK_SPLIT_OUT > 1) { S.init(MLAT / 256, 4, F.G, (int)blockIdx.x, (size_t)256 * 1024 * 2, (size_t)256 * 1024 * 2, 0); S.ntk = 16; S.nsplit = MK_SPLIT_OUT; S.xpm0 = MLAT / 256; S.xnp = MCTX / 256; }
            S.wgm = MK_WGM_OUT;
#ifdef MK_NULLEPI3
            if (rep) { EpiNull E{(float*)(F.ws + WS_G)}; pg8::gemm_phase(F.lds, g, S, E); } else
#endif
            { EpiRes E{X, rep ? gate_zero : mod + (size_t)l * 9 * 6144 + 2 * 1024, (float*)(F.ws + WS_SLAB)};
            pg8::gemm_phase(F.lds, g, S, E); }
        }
        SEAM(pb + 7);
        const int MF = last ? MLAT : MTOT;
        if (IN(pb + 8) && PHEN(8)) REPLOOP(8) { REPBAR(); norm_phase<1>(F, l, MF, false, false, moe && rep == 0, (!last && rep == 0 && MK_SPLIT_OUT > 1) ? mod + ((size_t)l * 9 + 8) * 6144 + 2 * 1024 : nullptr, MK_SPLIT_OUT); }
        SEAM(pb + 8);
        if (!moe) {
            if (IN(pb + 9) && PHEN(9)) REPLOOP(9) { REPBAR();
                pg8::Gemm g{HB, (const bf16*)(F.ws + WS_DW13), 1024, 1024, 1024};
                pg8::TileOrder S; S.init(MF / 256, 22, F.G, (int)blockIdx.x, (size_t)256 * 1024 * 2, (size_t)256 * 1024 * 2, 0);
                EpiSwiGlu E{(bf16*)(F.ws + WS_ACT), ACT_LD, 0, MK_BLOCKED_ACT};
                pg8::gemm_phase(F.lds, g, S, E);
            }
            SEAM(pb + 9);
            if (IN(pb + 10) && PHEN(10)) REPLOOP(10) { REPBAR();
                pg8::Gemm g{(const bf16*)(F.ws + WS_ACT), (const bf16*)(F.ws + WS_DW2), DFF, MK_BLOCKED_ACT ? 64 : ACT_LD, DFF, MK_BLOCKED_ACT ? 256 * 128 : 128};
                pg8::TileOrder S; S.init(MF / 256, 4, F.G, (int)blockIdx.x, (size_t)256 * ACT_LD * 2, (size_t)256 * DFF * 2, 0); if (!last && MK_SPLIT_FFN2 > 1) { S.init(MLAT / 256, 4, F.G, (int)blockIdx.x, (size_t)256 * ACT_LD * 2, (size_t)256 * DFF * 2, 0); S.ntk = 44; S.nsplit = MK_SPLIT_FFN2; S.xpm0 = MLAT / 256; S.xnp = MCTX / 256; }
                if (MK_BLOCKED_ACT) S.kpA = 2 * 256 * 128;
                S.wgm = MK_WGM_F2;
#ifdef MK_NULLEPI2
                if (rep) { EpiNull E{(float*)(F.ws + WS_YA)}; pg8::gemm_phase(F.lds, g, S, E); } else
#endif
                { EpiRes E{X, rep ? gate_zero : mod + (size_t)l * 9 * 6144 + 5 * 1024, (float*)(F.ws + WS_SLAB)};
                pg8::gemm_phase(F.lds, g, S, E); }
            }
            if (IN(pb + 10) && IN(pb + NPL)) SEAM_BODY();
        } else {
            if (IN(pb + 9) && PHEN(11)) { scatter_phase(F, l, MF, 1); }
            SEAM(pb + 9);
            const unsigned* cnt = (const unsigned*)F.ctl + CW_CNT + (l >> 1) * 16;
            {
                int segp[9]; moe_seg(cnt, segp);
                const int P = segp[8];
                if (IN(pb + 10) && PHEN(12)) REPLOOP(12) { REPBAR();
                    pg8::Gemm g{(const bf16*)(F.ws + WS_XS), (const bf16*)(F.ws + WS_W13), 1024, 1024, 1024};
                    pg8::MoeOrder S; S.nM = P; S.nN = 28; S.nwg = P * 28; S.G = F.G; S.c = (int)blockIdx.x; S.p0 = 0; S.sA = (size_t)256 * 1024 * 2; S.sB = (size_t)256 * 1024 * 2; S.a_local = 0; S.wgm = MK_WGM_M1;
#pragma unroll
                    for (int j = 0; j < 9; ++j) S.segp[j] = segp[j];
                    EpiSwiGlu E{(bf16*)(F.ws + WS_ACTS), DFE, 0, 0};
                    pg8::gemm_phase(F.lds, g, S, E);
                }
                SEAM(pb + 10);
                if (IN(pb + 11) && PHEN(13)) REPLOOP(13) { REPBAR();
                    pg8::Gemm g{(const bf16*)(F.ws + WS_ACTS), (const bf16*)(F.ws + WS_W2), DFE, DFE, DFE};
                    const int Pm = (P >> 6) << 6, xl = P - Pm;
                    const bool spl = MK_SPLIT_M2 && xl > 0 && xl <= 32 && F.G == 256;
                    pg8::MoeOrder S; S.nM = spl ? Pm : P; S.nN = 4; S.nwg = S.nM * 4; S.G = F.G; S.c = (int)blockIdx.x; S.p0 = 0; S.sA = (size_t)256 * DFE * 2; S.sB = (size_t)256 * DFE * 2; S.a_local = 0;
                    if (spl) { S.xpm0 = Pm; S.xnp = xl; S.ntk = 56; }
                    S.wgm = MK_WGM_M2;
#pragma unroll
                    for (int j = 0; j < 9; ++j) S.segp[j] = segp[j];
                    EpiPlain E{(bf16*)(F.ws + WS_YS), 1024, (bf16*)(F.ws + WS_SLAB), Pm};
                    pg8::gemm_phase(F.lds, g, S, E);
                }
                if (IN(pb + 11) && IN(pb + NPL)) SEAM_BODY();
            }
        }
        cv_prev_done = (cv_target < DEPTH) ? (cv_next < conv_ntiles(cv_target) ? cv_next : conv_ntiles(cv_target)) : 0;
    }
    if (IN(NPHASE - 1) && PHEN(21)) { norm_phase<2>(F, DEPTH, MLAT, false, true, false, nullptr, 1); }
#undef IN
#undef SEAM
}

extern "C" void kernel_launch(void* const* d_in, const int* in_sizes, int n_in, void* d_out, int out_size, void* d_ws, size_t ws_size, hipStream_t stream) {
    static int grid = 0;
    if (grid == 0) {
        if (n_in != 29 || out_size != MLAT * D || ws_size < WS_END) { fprintf(stderr, "kernel_launch: unexpected shapes (n_in %d out %d ws %zu)\n", n_in, out_size, ws_size); grid = -1; return; }
        int dev = 0, cus = 0, per_cu = 0;
        if (hipGetDevice(&dev) != hipSuccess || hipDeviceGetAttribute(&cus, hipDeviceAttributeMultiprocessorCount, dev) != hipSuccess) { grid = -1; return; }
        if (hipFuncSetAttribute((const void*)mk_fwd, hipFuncAttributeMaxDynamicSharedMemorySize, LDS_BYTES) != hipSuccess) { fprintf(stderr, "kernel_launch: hipFuncSetAttribute failed\n"); grid = -1; return; }
        if (hipOccupancyMaxActiveBlocksPerMultiprocessor(&per_cu, (const void*)mk_fwd, 512, LDS_BYTES) != hipSuccess || per_cu < 1) fprintf(stderr, "kernel_launch: occupancy query says %d\n", per_cu);
        (void)hipGetLastError();
        grid = cus;
        if (grid != 256) { fprintf(stderr, "kernel_launch: %d CUs, expected 256\n", cus); grid = 256; }
    }
    if (grid < 0) return;
    (void)hipMemsetAsync((char*)d_ws + WS_CTL, 0, CTL_ZERO_BYTES, stream);
    Args a{};
    for (int i = 0; i < 29; ++i) a.in[i] = (const float*)d_in[i];
    a.out = (float*)d_out; a.ws = (unsigned char*)d_ws;
#if MK_ONE_LAUNCH
    a.ph_lo = 0; a.ph_hi = NPHASE;
    hipLaunchKernelGGL(mk_fwd, dim3(grid), dim3(512), LDS_BYTES, stream, a);
#else
    for (int ph = 0; ph < NPHASE; ++ph) {
        if (ph >= 1 && ph < NPHASE - 1) { const int l = (ph - 1) / NPL, j = (ph - 1) % NPL; if (!(l & 1) && j >= 11) continue; }
        a.ph_lo = ph; a.ph_hi = ph + 1;
        hipLaunchKernelGGL(mk_fwd, dim3(grid), dim3(512), LDS_BYTES, stream, a);
    }
#endif
}
```

```cpp
#include <hip/hip_runtime.h>
#include <cstdio>
#include <cstdint>

#define MK_DIAG_PREPB 0
#define MK_DW2_LD 2816
#define MK_BLOCKED_ACT 0
#define MK_SSM_FUSED 1
#define MK_ACT_LD 2816
#define MK_WGM 4
#define MK_WGM_M1 4
#define MK_WGM_SSM 8
#define MK_WGM_INP 4
#define MK_WGM_GLU 4
#define MK_WGM_OUT 4
#define MK_WGM_F1 4
#define MK_WGM_F2 4
#define MK_WGM_M2 2
#define MK_SPLIT_M2 1
#define MK_CONV_SEAM 1
#define MK_ALIGN_EPI 1
#define MK_ATT_SPREAD 1
#define MK_WT_STORES 0
#define MK_SPLIT_OUT 4
#define MK_SPLIT_FFN2 4
#ifndef MK_ONE_LAUNCH
#define MK_ONE_LAUNCH 1
#endif

#define GAS __attribute__((address_space(1)))
#define LAS __attribute__((address_space(3)))
typedef unsigned short bf16;
typedef unsigned v4u __attribute__((ext_vector_type(4)));
typedef unsigned v2u __attribute__((ext_vector_type(2)));
typedef float f32x4 __attribute__((ext_vector_type(4)));
typedef float f32x2 __attribute__((ext_vector_type(2)));
typedef short bf16x8 __attribute__((ext_vector_type(8)));
typedef short bf16x4 __attribute__((ext_vector_type(4)));
typedef GAS unsigned gu32;

constexpr int D = 1024, NBATCH = 8, SEQ = 4096, DEPTH = 4, CTXL = 256;
constexpr int MLAT = NBATCH * SEQ, MCTX = NBATCH * CTXL, MTOT = MLAT + MCTX;
constexpr int SSMW = 512, NG = 32, NPS = 64, ATTW = 512, HD = 64, NH = 8, INW = 2048, DFF = 2816, NE = 8, DFE = 3584;
constexpr int NCRP = 1280, KY = 768;
constexpr float NORM_EPS = 1e-6f;
constexpr float QSCALE = 0.125f * 1.4426950408889634f;
constexpr float LOG2E = 1.4426950408889634f;
constexpr int MOE_MAXP = 280, MOE_HALFP = 140;
constexpr int DW2_LD = MK_DW2_LD;
constexpr int ACT_LD = MK_ACT_LD;

constexpr size_t MiB = 1u << 20;
constexpr size_t WS_CTL = 0, CTL_ZERO_BYTES = 1 * MiB;
constexpr size_t WS_MOD = 1 * MiB;
constexpr size_t WS_ROUTE = 2 * MiB;
constexpr size_t WS_BTS = 4 * MiB;
constexpr size_t WS_BTY = 12 * MiB;
constexpr size_t WS_WIN = 36 * MiB;
constexpr size_t WS_WOUT = 40 * MiB;
constexpr size_t WS_WGLU = 42 * MiB;
constexpr size_t WS_W13 = 44 * MiB;
constexpr size_t WS_W2 = 156 * MiB;
constexpr size_t WS_DW13 = 720 * MiB, WS_DW2 = 731 * MiB;
constexpr size_t WS_WIN1 = 740 * MiB, WS_WOUT1 = 744 * MiB, WS_WGLU1 = 746 * MiB;
__device__ __forceinline__ size_t ws_win(int l) { return (l & 1) ? WS_WIN1 : (size_t)(36 * MiB); }
__device__ __forceinline__ size_t ws_wout(int l) { return (l & 1) ? WS_WOUT1 : (size_t)(40 * MiB); }
__device__ __forceinline__ size_t ws_wglu(int l) { return (l & 1) ? WS_WGLU1 : (size_t)(42 * MiB); }
__device__ __forceinline__ size_t ws_w13(int l) { return (l & 1) ? WS_W13 : WS_DW13; }
__device__ __forceinline__ size_t ws_w2(int l) { return (l & 1) ? WS_W2 : WS_DW2; }
constexpr size_t WS_X = 212 * MiB;
constexpr size_t WS_HB = 348 * MiB;
constexpr size_t WS_AY = 416 * MiB;
constexpr size_t WS_S = 476 * MiB;
constexpr size_t WS_Q = 516 * MiB, WS_K = 550 * MiB, WS_V = 584 * MiB;
static_assert(WS_V - WS_K == WS_K - WS_Q, "q/k/v spacing");
constexpr size_t WS_G = 618 * MiB;
constexpr size_t WS_YA = 652 * MiB;
constexpr size_t WS_ACT = 416 * MiB;
constexpr size_t WS_XS = 838 * MiB;
constexpr size_t WS_ACTS = 348 * MiB;
constexpr size_t WS_YS = WS_XS;
constexpr size_t WS_KTG = 978 * MiB;
constexpr size_t WS_SLAB = 980 * MiB;
constexpr size_t WS_END = 1012 * MiB;
constexpr int CW_TMO = 0;
constexpr int CW_BAR = 4096;
constexpr int CW_CNT = 8192;
constexpr int CW_CUR = 8256;
constexpr int CW_BCNT = 24576;
constexpr int CW_Q = 12288;

constexpr int RING_BYTES = 131072;
constexpr int LDSCTL_OFF = 144 * 1024, MISC_OFF = LDSCTL_OFF + 320;
constexpr int LDS_BYTES = 152 * 1024;

#define RLX_AGENT __ATOMIC_RELAXED, __HIP_MEMORY_SCOPE_AGENT
#define LDS_WAIT() asm volatile("s_waitcnt lgkmcnt(0)" ::: "memory")
#define VM_WAIT() asm volatile("s_waitcnt vmcnt(0)" ::: "memory")
__device__ __forceinline__ unsigned f2bf(float f) { unsigned u = __builtin_bit_cast(unsigned, f); return (u + 0x7fffu + ((u >> 16) & 1u)) >> 16; }
__device__ __forceinline__ unsigned pk2(float lo, float hi) { return f2bf(lo) | (f2bf(hi) << 16); }
__device__ __forceinline__ float bf2f(unsigned short b) { return __builtin_bit_cast(float, ((unsigned)b) << 16); }
__device__ __forceinline__ float bflo(unsigned w) { return __builtin_bit_cast(float, w << 16); }
__device__ __forceinline__ float bfhi(unsigned w) { return __builtin_bit_cast(float, w & 0xffff0000u); }
typedef __bf16 bf16x2_t __attribute__((ext_vector_type(2)));
__device__ __forceinline__ unsigned cvt_pk_bf16(float lo, float hi) { const f32x2 v = {lo, hi}; const bf16x2_t b = __builtin_convertvector(v, bf16x2_t); return __builtin_bit_cast(unsigned, b); }
__device__ __forceinline__ float fast_rcp(float x) { return __builtin_amdgcn_rcpf(x); }
__device__ __forceinline__ float sigmoidf_(float x) { return fast_rcp(1.0f + __builtin_amdgcn_exp2f(-x * LOG2E)); }
__device__ __forceinline__ float siluf_(float x) { return x * sigmoidf_(x); }
__device__ __forceinline__ float gelu_tanh(float x) {
    const float u = 0.7978845608028654f * (x + 0.044715f * x * x * x);
    return x * sigmoidf_(2.0f * u);
}
__device__ __forceinline__ float wave_sum(float v) {
#pragma unroll
    for (int o = 1; o < 64; o <<= 1) v += __shfl_xor(v, o);
    return v;
}

__device__ __forceinline__ int lt_s(int v) { asm volatile("" : "+s"(v)); return v; }
__device__ __forceinline__ int lt_tid() { int t = threadIdx.x; asm volatile("" : "+v"(t)); return t; }

namespace pg8 {
#define PG8_LAS __attribute__((address_space(3)))
typedef unsigned short bf16_t;
constexpr int BM = 256, BK = 64, HALF = 128, HTB = HALF * BK * 2, STAGE_BYTES = 8 * HTB, NXCD = 8, WGM = MK_WGM;
__host__ __device__ __forceinline__ int lds_byte(int r, int c) { const int st = (r >> 4) * 2 + (c >> 5), rr = r & 15, cc = c & 31, ob = rr * 64 + cc * 2; return st * 1024 + (ob ^ (((ob >> 9) & 1) << 5)); }
__host__ __device__ __forceinline__ void stage_rc(int b, int& R, int& C) { const int st = b / 1024, sb = b % 1024, swz = sb ^ (((sb >> 9) & 1) << 5); R = (st >> 1) * 16 + swz / 64; C = (st & 1) * 32 + (swz % 64) / 2; }
__host__ __device__ __forceinline__ int perm32(int rho) { const int n = rho >> 4, i = rho & 15; return 8 * (i >> 2) + 4 * n + (i & 3); }

struct Unit { int pm, pn; size_t aoff, boff; int nt, atomic; };
struct Gemm { const bf16_t* A; const bf16_t* Bt; int K, lda, ldb; int kstepA = BK * 2; };

struct TileOrder {
    int nM, nN, nwg, G, c; size_t sA, sB; int bdiv;
    int wgm = WGM; int skip5 = 0; int kpA = 256;
    int ntk = 0, nsplit = 1, xpm0 = 0, xnp = 0;
    __device__ void init(int nM_, int nN_, int G_, int c_, size_t sA_, size_t sB_, int bdiv_) { nM = nM_; nN = nN_; nwg = nM * nN; G = G_; c = c_; sA = sA_; sB = sB_; bdiv = bdiv_; }
    __device__ bool next(int i, Unit& u) const {
        const long L = (long)i * G + c;
        u.nt = 0; u.atomic = 0;
        if (L >= nwg) {
            if (xnp == 0) return false;
            const int Lp = (int)(L - nwg); if (Lp >= xnp * nN * nsplit) return false;
            const int uu = Lp / nsplit, part = Lp - uu * nsplit;
            u.pm = xpm0 + uu / nN; u.pn = uu % nN; u.atomic = 1 + part;
            const int pairs = ntk / 2, base = pairs / nsplit, rem = pairs % nsplit; const int np = base + (part < rem ? 1 : 0), p0 = part * base + (part < rem ? part : rem);
            u.nt = 2 * np; u.aoff = (size_t)u.pm * sA + (size_t)p0 * kpA; u.boff = (size_t)u.pn * sB + (size_t)p0 * 256;
            return true;
        }
        int wgid = (int)L; { const int q = nwg / NXCD, r = nwg % NXCD, xcd = wgid % NXCD, off = wgid / NXCD; wgid = (xcd < r ? xcd * (q + 1) : r * (q + 1) + (xcd - r) * q) + off; }
        const int nig = wgm * nN, gid = wgid / nig, fm = gid * wgm, gsz = (nM - fm) < wgm ? (nM - fm) : wgm;
        u.pm = fm + ((wgid % nig) % gsz); u.pn = (wgid % nig) / gsz;
        if (skip5) u.pm = (u.pm >> 2) * 5 + (u.pm & 3);
        u.aoff = (size_t)u.pm * sA; u.boff = (size_t)(bdiv > 0 ? (u.pm / bdiv) * nN + u.pn : u.pn) * sB;
        return true;
    }
};
struct MoeOrder {
    int nM, nN, nwg, G, c, p0; size_t sA, sB; int segp[9]; int a_local;
    int wgm = WGM;
    int xpm0 = 0, xnp = 0, ntk = 0;
    __device__ bool next(int i, Unit& u) const {
        const long L = (long)i * G + c;
        int pl;
        if (L >= nwg) {
            if (xnp == 0) return false;
            const int Lp = (int)(L - nwg); if (Lp >= xnp * nN * 2) return false;
            const int uu = Lp >> 1, part = Lp & 1;
            pl = xpm0 + uu / nN; u.pn = uu % nN; u.pm = p0 + pl; u.nt = ntk / 2; u.atomic = 1 + part;
            int e = 0;
#pragma unroll
            for (int j = 1; j < 8; ++j) e += (u.pm >= segp[j]) ? 1 : 0;
            const size_t ko = (size_t)part * (size_t)(ntk / 2) * 128;
            u.aoff = (size_t)(a_local ? pl : u.pm) * sA + ko; u.boff = (size_t)(e * nN + u.pn) * sB + ko; return true;
        }
        int wgid = (int)L; { const int q = nwg / NXCD, r = nwg % NXCD, xcd = wgid % NXCD, off = wgid / NXCD; wgid = (xcd < r ? xcd * (q + 1) : r * (q + 1) + (xcd - r) * q) + off; }
        const int nig = wgm * nN, gid = wgid / nig, fm = gid * wgm, gsz = (nM - fm) < wgm ? (nM - fm) : wgm;
        pl = fm + ((wgid % nig) % gsz); u.pn = (wgid % nig) / gsz; u.pm = p0 + pl;
        int e = 0;
#pragma unroll
        for (int j = 1; j < 8; ++j) e += (u.pm >= segp[j]) ? 1 : 0;
        u.aoff = (size_t)(a_local ? pl : u.pm) * sA; u.boff = (size_t)(e * nN + u.pn) * sB; u.nt = 0; u.atomic = 0; return true;
    }
};

template <class Epi, class Sched>
__device__ __forceinline__ void gemm_phase(PG8_LAS unsigned char* lds, const Gemm g, const Sched& S, const Epi& E) {
    const int tid = lt_tid(), wid = __builtin_amdgcn_readfirstlane(tid >> 6), lane = tid & 63, wr = wid >> 2, wc = wid & 3, fr = lane & 15, fq = lane >> 4;
    const int K = g.K, nt = K / BK;
    unsigned voffA[2], voffB[2];
#pragma unroll
    for (int i = 0; i < 2; ++i) { int R, C; stage_rc(tid * 16 + i * 8192, R, C); const int Rb = Epi::PERM ? ((R & ~31) + perm32(R & 31)) : R;
        voffA[i] = (unsigned)(R * g.lda + C) * 2u; voffB[i] = (unsigned)(Rb * g.ldb + C) * 2u; }
    const size_t kstep = (size_t)(BK * 2), kstepA = (size_t)g.kstepA;
    const size_t hstepA = (size_t)HALF * g.lda * 2, hstepB = (size_t)HALF * g.ldb * 2;
    const unsigned ldsw = (unsigned)wid * 1024u;
    const int aoff = lds_byte(wr * 64 + fr, fq * 8), boff = lds_byte(wc * 32 + fr, fq * 8);
#define PG8_SA(b, h) (((b) * 2 + (h)) * HTB)
#define PG8_SB(b, h) ((4 + (b) * 2 + (h)) * HTB)
#define PG8_STAGE(bufoff, gbase, voff) do { _Pragma("unroll") for (int _i = 0; _i < 2; ++_i) \
        __builtin_amdgcn_global_load_lds((const unsigned*)((const char*)(gbase) + (voff)[_i]), (PG8_LAS unsigned*)(lds + (bufoff) + ldsw + _i * 8192), 16, 0, 0); } while (0)
#define PG8_LDA(dst, b, h) do { _Pragma("unroll") for (int m = 0; m < 4; ++m) _Pragma("unroll") for (int k = 0; k < 2; ++k) dst[m][k] = *(const PG8_LAS bf16x8*)(lds + PG8_SA(b, h) + aoff + m * 2048 + k * 1024); } while (0)
#define PG8_LDB(dst, b, h) do { _Pragma("unroll") for (int n = 0; n < 2; ++n) _Pragma("unroll") for (int k = 0; k < 2; ++k) dst[n][k] = *(const PG8_LAS bf16x8*)(lds + PG8_SB(b, h) + boff + n * 2048 + k * 1024); } while (0)
#define PG8_MMA(ai, bj, At, Bt) do { __builtin_amdgcn_s_setprio(1); _Pragma("unroll") for (int m = 0; m < 4; ++m) _Pragma("unroll") for (int n = 0; n < 2; ++n) _Pragma("unroll") for (int k = 0; k < 2; ++k) \
        acc[ai][bj][m][n] = __builtin_amdgcn_mfma_f32_16x16x32_bf16(Bt[n][k], At[m][k], acc[ai][bj][m][n], 0, 0, 0); __builtin_amdgcn_s_setprio(0); } while (0)
#define PG8_WAIT_V(n) asm volatile("s_waitcnt vmcnt(" #n ")" ::: "memory")
#define PG8_WAIT_L(n) asm volatile("s_waitcnt lgkmcnt(" #n ")" ::: "memory")
#define PG8_BAR __builtin_amdgcn_s_barrier()
#define PG8_SCHED __builtin_amdgcn_sched_barrier(0)
    Unit cur, nxt; int ui = 0;
    if (!S.next(0, cur)) return;
    f32x4 acc[2][2][4][2];
#pragma unroll
    for (int a = 0; a < 2; ++a)
#pragma unroll
        for (int b = 0; b < 2; ++b)
#pragma unroll
            for (int m = 0; m < 4; ++m)
#pragma unroll
                for (int n = 0; n < 2; ++n) acc[a][b][m][n] = (f32x4){0.f, 0.f, 0.f, 0.f};
    bf16x8 At[4][2], B0[2][2], B1[2][2];
    const char* cA = (const char*)g.A + cur.aoff; const char* cB = (const char*)g.Bt + cur.boff;
    PG8_STAGE(PG8_SB(0, 0), cB, voffB); PG8_STAGE(PG8_SB(0, 1), cB + hstepB, voffB); PG8_STAGE(PG8_SA(0, 0), cA, voffA); PG8_STAGE(PG8_SA(0, 1), cA + hstepA, voffA);
    if (wr == 1) PG8_BAR;
    PG8_WAIT_V(2); PG8_BAR;
    PG8_STAGE(PG8_SB(1, 0), cB + kstep, voffB); PG8_STAGE(PG8_SA(1, 0), cA + kstepA, voffA); PG8_STAGE(PG8_SB(1, 1), cB + hstepB + kstep, voffB);
    PG8_WAIT_V(6); PG8_BAR;
    for (;;) {
        const bool has_next = S.next(ui + 1, nxt);
        const char* nA = has_next ? (const char*)g.A + nxt.aoff : cA; const char* nB = has_next ? (const char*)g.Bt + nxt.boff : cB;
        const int ntc = cur.nt ? cur.nt : nt;
        for (int t = 0; t < ntc; t += 2) {
            const bool last = (t == ntc - 2);
            const char* a1 = cA + (size_t)(t + 1) * kstepA;
            const char* a2 = last ? nA : cA + (size_t)(t + 2) * kstepA; const char* b2 = last ? nB : cB + (size_t)(t + 2) * kstep;
            const char* a3 = a2 + kstepA; const char* b3 = b2 + kstep;
            PG8_LDB(B0, 0, 0); PG8_LDB(B1, 0, 1); PG8_SCHED; PG8_LDA(At, 0, 0); PG8_STAGE(PG8_SA(1, 1), a1 + hstepA, voffA);
            PG8_WAIT_V(8); PG8_WAIT_L(0); PG8_BAR; PG8_MMA(0, 0, At, B0); PG8_MMA(0, 1, At, B1); PG8_BAR; PG8_SCHED;
            PG8_LDA(At, 0, 1); PG8_STAGE(PG8_SB(0, 0), b2, voffB); PG8_STAGE(PG8_SB(0, 1), b2 + hstepB, voffB); PG8_STAGE(PG8_SA(0, 0), a2, voffA);
            PG8_WAIT_V(8); PG8_WAIT_L(0); PG8_BAR; PG8_MMA(1, 0, At, B0); PG8_MMA(1, 1, At, B1); PG8_BAR; PG8_SCHED;
            PG8_LDB(B0, 1, 0); PG8_LDB(B1, 1, 1); PG8_SCHED; PG8_LDA(At, 1, 0); PG8_STAGE(PG8_SA(0, 1), a2 + hstepA, voffA);
            PG8_WAIT_V(8); PG8_WAIT_L(0); PG8_BAR; PG8_MMA(0, 0, At, B0); PG8_MMA(0, 1, At, B1); PG8_BAR; PG8_SCHED;
            PG8_LDA(At, 1, 1); PG8_STAGE(PG8_SB(1, 0), b3, voffB); PG8_STAGE(PG8_SB(1, 1), b3 + hstepB, voffB); PG8_STAGE(PG8_SA(1, 0), a3, voffA);
            PG8_WAIT_V(8); PG8_WAIT_L(0); PG8_BAR; PG8_MMA(1, 0, At, B0); PG8_MMA(1, 1, At, B1); PG8_BAR; PG8_SCHED;
        }
        if (MK_ALIGN_EPI) { if (wr == 0) PG8_BAR; }
        E(acc, cur, wr, wc, fr, fq);
        if (!has_next) break;
#pragma unroll
        for (int a = 0; a < 2; ++a)
#pragma unroll
            for (int b = 0; b < 2; ++b)
#pragma unroll
                for (int m = 0; m < 4; ++m)
#pragma unroll
                    for (int n = 0; n < 2; ++n) acc[a][b][m][n] = (f32x4){0.f, 0.f, 0.f, 0.f};
        cur = nxt; cA = nA; cB = nB; ++ui;
        if (MK_ALIGN_EPI) { if (wr == 1) PG8_BAR; }
    }
    PG8_WAIT_V(0);
    if (!MK_ALIGN_EPI) { if (wr == 0) PG8_BAR; }
    PG8_BAR;
#undef PG8_SA
#undef PG8_SB
#undef PG8_STAGE
#undef PG8_LDA
#undef PG8_LDB
#undef PG8_MMA
#undef PG8_WAIT_V
#undef PG8_WAIT_L
#undef PG8_BAR
#undef PG8_SCHED
}
}

typedef const f32x4 (&AccRef)[2][2][4][2];
__device__ __forceinline__ v4u pack8(const f32x4& v0, const f32x4& v1) { v4u w; w.x = cvt_pk_bf16(v0[0], v0[1]); w.y = cvt_pk_bf16(v0[2], v0[3]); w.z = cvt_pk_bf16(v1[0], v1[1]); w.w = cvt_pk_bf16(v1[2], v1[3]); return w; }

__device__ __forceinline__ void st16_wt(void* p, v4u v) {
#if MK_WT_STORES
    asm volatile("global_store_dwordx4 %0, %1, off sc1" :: "v"(p), "v"(v) : "memory");
#else
    *(v4u*)p = v;
#endif
}
struct EpiInProj {
    static constexpr bool PERM = true;
    bf16* AY; bf16* Q; bf16* Kb; bf16* V;
    __device__ __forceinline__ void operator()(AccRef acc, const pg8::Unit& u, int wr, int wc, int fr, int fq) const {
        const int row0 = u.pm * 256 + wr * 64 + fr;
        const int sel = u.pn >> 1;
#pragma unroll
        for (int ai = 0; ai < 2; ++ai)
#pragma unroll
            for (int m = 0; m < 4; ++m) {
                const int row = row0 + ai * 128 + m * 16;
#pragma unroll
                for (int bj = 0; bj < 2; ++bj) {
                    const int j0 = (u.pn & 1) * 256 + bj * 128 + wc * 32 + 8 * fq;
                    f32x4 v0 = acc[ai][bj][m][0], v1 = acc[ai][bj][m][1];
                    if (sel == 0) {
                        const int g = j0 >> 4, hh0 = j0 & 15, cr = row >> 5, s = row & 31;
                        *(v4u*)(AY + ((size_t)(g * NCRP + cr) * KY + s * 16 + hh0)) = pack8(v0, v1);
                    } else {
                        bf16* base = Q + (size_t)(sel - 1) * ((WS_K - WS_Q) / 2);
                        if (sel == 1) { v0 = v0 * QSCALE; v1 = v1 * QSCALE; }
                        *(v4u*)(base + (size_t)row * 512 + j0) = pack8(v0, v1);
                    }
                }
            }
    }
};
struct EpiS {
    static constexpr bool PERM = false;
    float* S;
    __device__ __forceinline__ void operator()(AccRef acc, const pg8::Unit& u, int wr, int wc, int fr, int fq) const {
        const int row0 = u.pm * 256 + wr * 64 + fr, col0 = wc * 32 + 4 * fq;
#pragma unroll
        for (int ai = 0; ai < 2; ++ai)
#pragma unroll
            for (int m = 0; m < 4; ++m) { float* rowp = S + (size_t)(row0 + ai * 128 + m * 16) * 256 + col0;
#pragma unroll
                for (int bj = 0; bj < 2; ++bj)
#pragma unroll
                    for (int n = 0; n < 2; ++n) *(f32x4*)(rowp + bj * 128 + n * 16) = acc[ai][bj][m][n]; }
    }
};
struct EpiY {
    static constexpr bool PERM = true;
    bf16* G;
    __device__ __forceinline__ void operator()(AccRef acc, const pg8::Unit& u, int wr, int wc, int fr, int fq) const {
        const int g = u.pm / 5, crb = (u.pm - g * 5) * 256 + wr * 64 + fr;
#pragma unroll
        for (int ai = 0; ai < 2; ++ai)
#pragma unroll
            for (int m = 0; m < 4; ++m) {
                const int cr = crb + ai * 128 + m * 16;
                if (cr < 1088) {
#pragma unroll
                    for (int bj = 0; bj < 2; ++bj) {
                        const int nl = u.pn * 256 + bj * 128 + wc * 32 + 8 * fq, t = nl >> 4, hh0 = nl & 15;
                        f32x4 v0 = acc[ai][bj][m][0], v1 = acc[ai][bj][m][1];
#pragma unroll
                        for (int j = 0; j < 4; ++j) { v0[j] = gelu_tanh(v0[j]); v1[j] = gelu_tanh(v1[j]); }
                        *(v4u*)(G + (size_t)(cr * 32 + t) * 512 + g * 16 + hh0) = pack8(v0, v1);
                    }
                }
            }
    }
};
struct EpiGlu {
    static constexpr bool PERM = true;
    const bf16* G; const float* bias; bf16* YA;
    __device__ __forceinline__ void operator()(AccRef acc, const pg8::Unit& u, int wr, int wc, int fr, int fq) const {
        const int row0 = u.pm * 256 + wr * 64 + fr;
#pragma unroll
        for (int ai = 0; ai < 2; ++ai)
#pragma unroll
            for (int m = 0; m < 4; ++m) {
                const int row = row0 + ai * 128 + m * 16;
#pragma unroll
                for (int bj = 0; bj < 2; ++bj) {
                    const int c0 = u.pn * 256 + bj * 128 + wc * 32 + 8 * fq;
                    const v4u gv = *(const v4u*)(G + (size_t)row * 512 + c0);
                    const f32x4 b0 = *(const f32x4*)(bias + c0), b1 = *(const f32x4*)(bias + c0 + 4);
                    f32x4 v0 = acc[ai][bj][m][0] + b0, v1 = acc[ai][bj][m][1] + b1;
                    const float gg[8] = {bflo(gv.x), bfhi(gv.x), bflo(gv.y), bfhi(gv.y), bflo(gv.z), bfhi(gv.z), bflo(gv.w), bfhi(gv.w)};
#pragma unroll
                    for (int j = 0; j < 4; ++j) { v0[j] = gg[j] * sigmoidf_(v0[j]); v1[j] = gg[4 + j] * sigmoidf_(v1[j]); }
                    *(v4u*)(YA + (size_t)row * 1024 + c0) = pack8(v0, v1);
                }
            }
    }
};
struct EpiRes {
    static constexpr bool PERM = false;
    float* X; const float* gate; float* slab;
    __device__ __forceinline__ void operator()(AccRef acc, const pg8::Unit& u, int wr, int wc, int fr, int fq) const {
        const int row0 = u.pm * 256 + wr * 64 + fr, col0 = u.pn * 256 + wc * 32 + 4 * fq;
        const int rb = u.pm * 256; const int bidx = rb < MLAT ? (rb >> 12) : 8;
        const float* gp = gate + (size_t)bidx * 6144 + col0;
        f32x4 gv[2][2];
#pragma unroll
        for (int bj = 0; bj < 2; ++bj)
#pragma unroll
            for (int n = 0; n < 2; ++n) gv[bj][n] = *(const f32x4*)(gp + bj * 128 + n * 16);
        if (u.atomic) {
            float* sl = slab + (size_t)(u.atomic - 1) * MCTX * 1024;
#pragma unroll
            for (int ai = 0; ai < 2; ++ai)
#pragma unroll
                for (int m = 0; m < 4; ++m) { float* rowp = sl + (size_t)(row0 - MLAT + ai * 128 + m * 16) * 1024 + col0;
#pragma unroll
                    for (int bj = 0; bj < 2; ++bj)
#pragma unroll
                        for (int n = 0; n < 2; ++n) *(f32x4*)(rowp + bj * 128 + n * 16) = acc[ai][bj][m][n]; }
        } else {
#pragma unroll
            for (int ai = 0; ai < 2; ++ai)
#pragma unroll
                for (int m = 0; m < 4; ++m) { float* rowp = X + (size_t)(row0 + ai * 128 + m * 16) * 1024 + col0;
#pragma unroll
                    for (int bj = 0; bj < 2; ++bj)
#pragma unroll
                        for (int n = 0; n < 2; ++n) { f32x4* p = (f32x4*)(rowp + bj * 128 + n * 16); *p = *p + gv[bj][n] * acc[ai][bj][m][n]; }
                    asm volatile("" ::: "memory"); }
        }
    }
};
struct EpiSwiGlu {
    static constexpr bool PERM = true;
    bf16* O; int ldo; int row_sub; int blocked;
    __device__ __forceinline__ void operator()(AccRef acc, const pg8::Unit& u, int wr, int wc, int fr, int fq) const {
        const int row0 = u.pm * 256 - row_sub + wr * 64 + fr, c0 = u.pn * 128 + wc * 32 + 8 * fq;
#pragma unroll
        for (int ai = 0; ai < 2; ++ai)
#pragma unroll
            for (int m = 0; m < 4; ++m) {
                f32x4 a0 = acc[ai][0][m][0], a1 = acc[ai][0][m][1]; const f32x4 b0 = acc[ai][1][m][0], b1 = acc[ai][1][m][1];
#pragma unroll
                for (int j = 0; j < 4; ++j) { a0[j] = siluf_(a0[j]) * b0[j]; a1[j] = siluf_(a1[j]) * b1[j]; }
                const int row = row0 + ai * 128 + m * 16;
                bf16* p = blocked ? O + ((size_t)((row >> 8) * (ldo >> 6) + (c0 >> 6)) * 256 + (row & 255)) * 64 + (c0 & 63) : O + (size_t)row * ldo + c0;
                st16_wt(p, pack8(a0, a1));
            }
    }
};
struct EpiPlain {
    static constexpr bool PERM = true;
    bf16* O; int ldo; bf16* O2; int xpm0;
    __device__ __forceinline__ void operator()(AccRef acc, const pg8::Unit& u, int wr, int wc, int fr, int fq) const {
        const int rt = wr * 64 + fr, ct = wc * 32 + 8 * fq;
        bf16* base; int ld;
        if (u.atomic == 2) { base = O2 + (size_t)((u.pm - xpm0) * 4 + u.pn) * 65536 + (size_t)rt * 256 + ct; ld = 256; }
        else { base = O + (size_t)(u.pm * 256 + rt) * ldo + u.pn * 256 + ct; ld = ldo; }
#pragma unroll
        for (int ai = 0; ai < 2; ++ai)
#pragma unroll
            for (int m = 0; m < 4; ++m)
#pragma unroll
                for (int bj = 0; bj < 2; ++bj)
                    *(v4u*)(base + (size_t)(ai * 128 + m * 16) * ld + bj * 128) = pack8(acc[ai][bj][m][0], acc[ai][bj][m][1]);
    }
};

#define XB_TMO      128
#define XB_XCNT(j)  (256  + 64 * (j))
#define XB_XSUB(j)  (1280 + 64 * (j))
#define XB_XGEN(j)  (2304 + 64 * (j))
#define XB_TOP      3328
#define XB_TOPGEN   3392
#define XCD_BAR_WORDS 3456
#define XB_SPIN_CAP (1u << 18)
__device__ __forceinline__ unsigned xb_ld(unsigned* p)              { return __hip_atomic_load(p, __ATOMIC_RELAXED, __HIP_MEMORY_SCOPE_AGENT); }
__device__ __forceinline__ unsigned xb_add(unsigned* p, unsigned v) { return __hip_atomic_fetch_add(p, v, __ATOMIC_RELAXED, __HIP_MEMORY_SCOPE_AGENT); }
__device__ __forceinline__ unsigned xb_xcc_id() { return (unsigned)__builtin_amdgcn_s_getreg((3 << 11) | 20) & 0xFu; }
#define XB_SPIN(cond, bar) do { unsigned _sp = 0; while (cond) { __builtin_amdgcn_s_sleep(1); \
    if ((++_sp & 255u) == 0u) { if (xb_ld(&(bar)[XB_TMO])) break; if (_sp > XB_SPIN_CAP) { atomicAdd(&(bar)[XB_TMO], 1u); break; } } } } while (0)
struct XcdBarrier { unsigned* bar; unsigned x; volatile LAS unsigned* st; };
__device__ __forceinline__ XcdBarrier xcd_barrier_post(unsigned* bar, volatile LAS unsigned* st) {
    XcdBarrier b; b.bar = bar; b.x = xb_xcc_id(); b.st = st;
    if (threadIdx.x == 0) (void)xb_add(&bar[XB_XCNT(b.x)], 1u);
    return b;
}
__device__ __forceinline__ void xcd_barrier_complete(unsigned* bar, unsigned x, unsigned& nloc, unsigned& nx) {
    const unsigned G = gridDim.x * gridDim.y * gridDim.z;
    unsigned sum, cnt, mine, sp = 0u;
    for (;;) {
        sum = 0u; cnt = 0u; mine = 0u;
#pragma unroll
        for (unsigned j = 0; j < 16; ++j) { const unsigned c = xb_ld(&bar[XB_XCNT(j)]); sum += c; cnt += (c > 0u) ? 1u : 0u; mine = (j == x) ? c : mine; }
        if (sum == G) break;
        __builtin_amdgcn_s_sleep(1);
        if ((++sp & 255u) == 0u) { if (xb_ld(&bar[XB_TMO])) break; if (sp > XB_SPIN_CAP) { atomicAdd(&bar[XB_TMO], 1u); break; } }
    }
    nloc = mine > 0u ? mine : 1u; nx = cnt > 0u ? cnt : 1u;
}
__device__ __forceinline__ void xcd_barrier(const XcdBarrier& b) {
    asm volatile("s_waitcnt vmcnt(0)" ::: "memory");
    __syncthreads();
    if (lt_tid() == 0) {
        unsigned* bar = b.bar;
        __builtin_amdgcn_s_waitcnt(0);
        unsigned nloc = b.st[0], nx = b.st[1];
        if (nloc == 0u) { xcd_barrier_complete(bar, b.x, nloc, nx); b.st[0] = nloc; b.st[1] = nx; }
        const unsigned old = xb_add(&bar[XB_XSUB(b.x)], 1u);
        const unsigned gen = old / nloc;
        if (old + 1u == (gen + 1u) * nloc) {
            __builtin_amdgcn_fence(__ATOMIC_RELEASE, "agent");
            asm volatile("s_waitcnt vmcnt(0)" ::: "memory");
            const unsigned og = xb_add(&bar[XB_TOP], 1u);
            const unsigned tg = og / nx;
            if (og + 1u == (tg + 1u) * nx) xb_add(&bar[XB_TOPGEN], 1u);
            else XB_SPIN(xb_ld(&bar[XB_TOPGEN]) == tg, bar);
            __builtin_amdgcn_fence(__ATOMIC_ACQUIRE, "agent");
            xb_add(&bar[XB_XGEN(b.x)], 1u);
            asm volatile("s_waitcnt vmcnt(0)" ::: "memory");
        } else {
            XB_SPIN(xb_ld(&bar[XB_XGEN(b.x)]) == gen, bar);
            __builtin_amdgcn_fence(__ATOMIC_ACQUIRE, "agent");
            asm volatile("s_waitcnt vmcnt(0)" ::: "memory");
        }
    }
    __syncthreads();
}

struct XbTok { unsigned gen, tg; int role; };
__device__ __forceinline__ XbTok xcd_arrive(const XcdBarrier& b) {
    asm volatile("s_waitcnt vmcnt(0)" ::: "memory");
    __syncthreads();
    XbTok t; t.gen = 0u; t.tg = 0u; t.role = 0;
    if (lt_tid() == 0) {
        unsigned* bar = b.bar;
        __builtin_amdgcn_s_waitcnt(0);
        unsigned nloc = b.st[0], nx = b.st[1];
        if (nloc == 0u) { xcd_barrier_complete(bar, b.x, nloc, nx); b.st[0] = nloc; b.st[1] = nx; }
        const unsigned old = xb_add(&bar[XB_XSUB(b.x)], 1u);
        t.gen = old / nloc;
        if (old + 1u == (t.gen + 1u) * nloc) {
            __builtin_amdgcn_fence(__ATOMIC_RELEASE, "agent");
            asm volatile("s_waitcnt vmcnt(0)" ::: "memory");
            const unsigned og = xb_add(&bar[XB_TOP], 1u);
            t.tg = og / nx;
            if (og + 1u == (t.tg + 1u) * nx) { xb_add(&bar[XB_TOPGEN], 1u); t.role = 2; } else t.role = 1;
        }
    }
    return t;
}
__device__ __forceinline__ void xcd_wait(const XcdBarrier& b, const XbTok& t) {
    if (lt_tid() == 0) {
        unsigned* bar = b.bar;
        if (t.role) {
            if (t.role == 1) XB_SPIN(xb_ld(&bar[XB_TOPGEN]) == t.tg, bar);
            __builtin_amdgcn_fence(__ATOMIC_ACQUIRE, "agent");
            xb_add(&bar[XB_XGEN(b.x)], 1u);
            asm volatile("s_waitcnt vmcnt(0)" ::: "memory");
        } else {
            XB_SPIN(xb_ld(&bar[XB_XGEN(b.x)]) == t.gen, bar);
            __builtin_amdgcn_fence(__ATOMIC_ACQUIRE, "agent");
            asm volatile("s_waitcnt vmcnt(0)" ::: "memory");
        }
    }
    __syncthreads();
}

struct Args { const float* in[29]; float* out; unsigned char* ws; int ph_lo, ph_hi; };
enum InIdx { I_X = 0, I_C, I_CTX, I_CCTX, I_WMOD, I_BMOD, I_GMIX, I_GFFN, I_WIN, I_WOUT, I_ARE, I_AIM, I_LOGSTEP, I_BRE, I_BIM, I_CRE, I_CIM, I_SSMD, I_GLUW, I_GLUB, I_RPB,
             I_FW1, I_FW3, I_FW2, I_ROUTER, I_MW1, I_MW3, I_MW2, I_GFINAL };
struct Ctx {
    LAS unsigned char* lds; unsigned char* ws; gu32* ctl;
    int tid, lane, wave, vcu, G;
    const float* const* in; float* out;
};
__device__ __forceinline__ int batch_slot(int m) { return m < MLAT ? (m >> 12) : 8; }

__device__ __forceinline__ void mod_phase(Ctx& F) {
    F.tid = lt_tid(); F.lane = F.tid & 63;
    LAS float* sc = (LAS float*)F.lds;
    LAS float* red = sc + 9 * 1024;
    const float* c = F.in[I_C]; const float* cc = F.in[I_CCTX];
    for (int i = F.tid; i < 9 * 1024; i += 512) { const float v = i < 8192 ? c[i] : cc[i - 8192]; sc[i] = siluf_(v); }
    __syncthreads();
    float* mod = (float*)(F.ws + WS_MOD);
    const int col = F.tid & 31, kg = F.tid >> 5;
    for (int it = F.vcu; it < 4 * 192; it += F.G) {
        const int l = it / 192, c0 = (it % 192) * 32;
        const float* W = F.in[I_WMOD] + (size_t)l * 1024 * 6144 + c0 + col;
        float acc[9];
#pragma unroll
        for (int r = 0; r < 9; ++r) acc[r] = 0.f;
#pragma unroll 4
        for (int kk = 0; kk < 64; ++kk) { const int k = kg * 64 + kk; const float w = W[(size_t)k * 6144];
#pragma unroll
            for (int r = 0; r < 9; ++r) acc[r] += sc[r * 1024 + k] * w; }
#pragma unroll
        for (int r = 0; r < 9; ++r) red[(kg * 9 + r) * 32 + col] = acc[r];
        __syncthreads();
        if (F.tid < 288) { const int r = F.tid >> 5; float s = F.in[I_BMOD][l * 6144 + c0 + col];
#pragma unroll
            for (int q = 0; q < 16; ++q) s += red[(q * 9 + r) * 32 + col];
            mod[((size_t)l * 9 + r) * 6144 + c0 + col] = s; }
        __syncthreads();
    }
}

__device__ __forceinline__ void tr_item(const float* W, int K, int N, bf16* WT, int mode, LAS float* scr, int item, int lane, int ldk = 0) {
    if (ldk == 0) ldk = K;
    const int nblk = N / 64, kb = item / nblk, nb = item % nblk, k0 = 64 * kb, n0 = 64 * nb;
    const int drow0 = mode == 0 ? n0 : ((n0 >> 7) * 256 + (mode == 2 ? 128 : 0) + (n0 & 127));
    const float* src = W + (size_t)(k0 + (lane >> 4)) * N + n0 + 4 * (lane & 15);
    f32x4 v[16];
#pragma unroll
    for (int i = 0; i < 16; ++i) v[i] = *(const GAS f32x4*)(src + (size_t)(4 * i) * N);
#pragma unroll
    for (int i = 0; i < 16; ++i) { LAS float* d = scr + (4 * i + (lane >> 4)) * 65 + 4 * (lane & 15); d[0] = v[i][0]; d[1] = v[i][1]; d[2] = v[i][2]; d[3] = v[i][3]; }
    LDS_WAIT(); asm volatile("" ::: "memory");
    const int c = lane & 7;
#pragma unroll
    for (int j = 0; j < 8; ++j) { const int n = (lane >> 3) + 8 * j; const LAS float* s = scr + (8 * c) * 65 + n;
        v4u o; o.x = pk2(s[0 * 65], s[1 * 65]); o.y = pk2(s[2 * 65], s[3 * 65]); o.z = pk2(s[4 * 65], s[5 * 65]); o.w = pk2(s[6 * 65], s[7 * 65]);
        *(GAS v4u*)(WT + (size_t)(drow0 + n) * ldk + k0 + 8 * c) = o; }
    LDS_WAIT(); asm volatile("" ::: "memory");
}
constexpr int CV_IN = 16 * 32, CV_OUT = 16 * 16, CV_GLU = 8 * 8, CV_D13 = 16 * 44, CV_D2 = 44 * 16, CV_M13 = 16 * 56, CV_M2 = 56 * 16;
__device__ __forceinline__ int conv_ntiles(int l) { return CV_IN + CV_OUT + CV_GLU + ((l & 1) ? 8 * (2 * CV_M13 + CV_M2) : (2 * CV_D13 + CV_D2)); }
__device__ __forceinline__ void conv_tile(Ctx& F, int l, int r, LAS float* scr, int lane) {
    const bool moe = (l & 1) != 0; const int li = l >> 1;
    bf16* W13 = (bf16*)(F.ws + ws_w13(l)); bf16* W2 = (bf16*)(F.ws + ws_w2(l));
    if (r < CV_IN) { tr_item(F.in[I_WIN] + (size_t)l * 1024 * 2048, 1024, 2048, (bf16*)(F.ws + ws_win(l)), 0, scr, r, lane); return; } r -= CV_IN;
    if (r < CV_OUT) { tr_item(F.in[I_WOUT] + (size_t)l * 1024 * 1024, 1024, 1024, (bf16*)(F.ws + ws_wout(l)), 0, scr, r, lane); return; } r -= CV_OUT;
    if (r < CV_GLU) { tr_item(F.in[I_GLUW] + (size_t)l * 512 * 512, 512, 512, (bf16*)(F.ws + ws_wglu(l)), 0, scr, r, lane); return; } r -= CV_GLU;
    if (!moe) {
        if (r < CV_D13) { tr_item(F.in[I_FW1] + (size_t)li * 1024 * DFF, 1024, DFF, W13, 1, scr, r, lane); return; } r -= CV_D13;
        if (r < CV_D13) { tr_item(F.in[I_FW3] + (size_t)li * 1024 * DFF, 1024, DFF, W13, 2, scr, r, lane); return; } r -= CV_D13;
        tr_item(F.in[I_FW2] + (size_t)li * DFF * 1024, DFF, 1024, W2, 0, scr, r, lane, DW2_LD);
    } else {
        const int per = 2 * CV_M13 + CV_M2, e = r / per; r -= e * per;
        const size_t eo = (size_t)(li * 8 + e) * 1024 * DFE;
        if (r < CV_M13) { tr_item(F.in[I_MW1] + eo, 1024, DFE, W13 + (size_t)e * 7168 * 1024, 1, scr, r, lane); return; } r -= CV_M13;
        if (r < CV_M13) { tr_item(F.in[I_MW3] + eo, 1024, DFE, W13 + (size_t)e * 7168 * 1024, 2, scr, r, lane); return; } r -= CV_M13;
        tr_item(F.in[I_MW2] + eo, DFE, 1024, W2 + (size_t)e * 1024 * DFE, 0, scr, r, lane);
    }
}
__device__ __forceinline__ void wconv_drain(Ctx& F, int l, unsigned x) {
    volatile LAS int* bc = (volatile LAS int*)(F.lds + LDSCTL_OFF + 512);
    const int n = conv_ntiles(l);
    for (int rr = 0; rr < 8; ++rr) {
        const int r = (rr + (int)(x & 7u)) & 7;
        for (;;) {
            __syncthreads();
            if (threadIdx.x == 0) { gu32* q = F.ctl + CW_Q + 64 * (l * 8 + r); int c = 0x7fffff;
                if ((int)((__hip_atomic_load(q, RLX_AGENT) * 8u + (unsigned)r) * 8u) < n) c = (int)__hip_atomic_fetch_add(q, 1u, RLX_AGENT);
                bc[0] = c; }
            __syncthreads();
            const int t = (bc[0] * 8 + r) * 8 + F.wave;
            if ((bc[0] * 8 + r) * 8 >= n) break;
            if (t < n) conv_tile(F, l, t, (LAS float*)(F.lds + F.wave * 16640), lt_tid() & 63);
        }
    }
}
__device__ __forceinline__ void wconv_phase(Ctx& F, int l, int t_begin) {
    const int lane = lt_tid() & 63;
    LAS float* scr = (LAS float*)(F.lds + F.wave * 16640);
    const int gw = F.vcu * 8 + F.wave, NGW = F.G * 8, n = conv_ntiles(l);
    for (int it = t_begin + gw; it < n; it += NGW) conv_tile(F, l, it, scr, lane);
}

__device__ __forceinline__ void sincos_red(float x, float& s, float& c) {
    const float k = rintf(x * 0.15915494309189535f);
    float r = fmaf(-k, 6.28318548202514648f, x); r = fmaf(-k, -1.7484555e-07f, r);
    s = __sinf(r); c = __cosf(r);
}
#define CCI(dir, hh, p) ((((dir) * 16 + (hh)) * 65 + (p)) * 2)
#define KTI(dir, tau, hh, h) (((((dir) * 16 + (hh)) * 16 + (h)) * 32) + (tau))
__device__ __forceinline__ void ssm_prepA(Ctx& F, int l, int g, int part8) {
    F.tid = lt_tid(); F.lane = F.tid & 63;
    LAS float* LAM = (LAS float*)F.lds;
    LAS float* CC = LAM + 8448;
    LAS float* BB = CC + 4160;
    const int tid = F.tid;
    __syncthreads();
    if (tid < 128) {
        const int dir = tid >> 6, p = tid & 63; const int pi = ((l * 2 + dir) * 32 + g) * 64 + p;
        const float are = fminf(F.in[I_ARE][pi], -1e-4f), aim = F.in[I_AIM][pi];
        const float dt = __expf(F.in[I_LOGSTEP][(l * 2 + dir) * 32 + g]);
        const float th = aim * dt, ad = are * dt;
        for (int e = 0; e <= 32; ++e) { float sn, cs; sincos_red(th * (float)e, sn, cs); const float mg = __expf(ad * (float)e);
            LAM[((dir * 64 + p) * 33 + e) * 2] = mg * cs; LAM[((dir * 64 + p) * 33 + e) * 2 + 1] = mg * sn; }
        float s1, c1; sincos_red(th, s1, c1); const float m1 = __expf(ad); const float lre = m1 * c1, lim = m1 * s1;
        const float den = are * are + aim * aim;
        const float zre = ((lre - 1.f) * are + lim * aim) / den, zim = (lim * are - (lre - 1.f) * aim) / den;
        for (int h = 0; h < 16; ++h) { const float br = F.in[I_BRE][(size_t)pi * 16 + h], bi = F.in[I_BIM][(size_t)pi * 16 + h];
            BB[((dir * 64 + p) * 16 + h) * 2] = zre * br - zim * bi; BB[((dir * 64 + p) * 16 + h) * 2 + 1] = zre * bi + zim * br; }
    }
    for (int idx = tid; idx < 2048; idx += 512) { const int dir = idx >> 10, rem = idx & 1023, hh = rem >> 6, p = rem & 63; const size_t gi = ((size_t)((l * 2 + dir) * 32 + g)) * 1024 + rem;
        CC[CCI(dir, hh, p)] = F.in[I_CRE][gi]; CC[CCI(dir, hh, p) + 1] = F.in[I_CIM][gi]; }
    __syncthreads();
    {
        const int dir = tid >> 8, hh = (tid >> 4) & 15, h = tid & 15, t0 = 4 * part8;
        float a0 = 0.f, a1 = 0.f, a2 = 0.f, a3 = 0.f;
        for (int p = 0; p < 64; ++p) {
            const float cr = CC[CCI(dir, hh, p)], ci = CC[CCI(dir, hh, p) + 1];
            const float br = BB[((dir * 64 + p) * 16 + h) * 2], bi = BB[((dir * 64 + p) * 16 + h) * 2 + 1];
            const float gr = cr * br - ci * bi, gi = cr * bi + ci * br;
            const LAS float* lp = LAM + ((dir * 64 + p) * 33 + t0) * 2;
            a0 += gr * lp[0] - gi * lp[1]; a1 += gr * lp[2] - gi * lp[3]; a2 += gr * lp[4] - gi * lp[5]; a3 += gr * lp[6] - gi * lp[7];
        }
        float* KTG = (float*)(F.ws + WS_KTG) + (size_t)g * 16384;
        *(f32x4*)(KTG + KTI(dir, t0, hh, h)) = (f32x4){a0, a1, a2, a3};
    }
    bf16* BtS = (bf16*)(F.ws + WS_BTS) + (size_t)g * 256 * 512;
    bf16* BtY = (bf16*)(F.ws + WS_BTY) + (size_t)g * 512 * KY;
    for (int task = tid; task < 32 * 32; task += 512) {
        const int n = part8 * 32 + (task >> 5), s = task & 31, dir = n >> 7, part = (n >> 6) & 1, p = n & 63, e = dir ? s : 31 - s;
        const float lr = LAM[((dir * 64 + p) * 33 + e) * 2], li = LAM[((dir * 64 + p) * 33 + e) * 2 + 1];
        float v[16];
#pragma unroll
        for (int h = 0; h < 16; ++h) { const float br = BB[((dir * 64 + p) * 16 + h) * 2], bi = BB[((dir * 64 + p) * 16 + h) * 2 + 1]; v[h] = part ? (lr * bi + li * br) : (lr * br - li * bi); }
        v4u o0, o1; o0.x = pk2(v[0], v[1]); o0.y = pk2(v[2], v[3]); o0.z = pk2(v[4], v[5]); o0.w = pk2(v[6], v[7]); o1.x = pk2(v[8], v[9]); o1.y = pk2(v[10], v[11]); o1.z = pk2(v[12], v[13]); o1.w = pk2(v[14], v[15]);
        v4u* dst = (v4u*)(BtS + (size_t)n * 512 + s * 16); dst[0] = o0; dst[1] = o1;
    }
    for (int task = tid; task < 64 * 16; task += 512) {
        const int n = part8 * 64 + (task >> 4), ch = task & 15, t = n >> 4, hh = n & 15, dir = ch >> 3, part = (ch >> 2) & 1, p0 = (ch & 3) * 16, e = dir ? 32 - t : t + 1;
        float v[16];
#pragma unroll
        for (int j = 0; j < 16; ++j) { const int p = p0 + j; const float cr = CC[CCI(dir, hh, p)], ci = CC[CCI(dir, hh, p) + 1];
            const float lr = LAM[((dir * 64 + p) * 33 + e) * 2], li = LAM[((dir * 64 + p) * 33 + e) * 2 + 1]; v[j] = part ? -(cr * li + ci * lr) : (cr * lr - ci * li); }
        v4u o0, o1; o0.x = pk2(v[0], v[1]); o0.y = pk2(v[2], v[3]); o0.z = pk2(v[4], v[5]); o0.w = pk2(v[6], v[7]); o1.x = pk2(v[8], v[9]); o1.y = pk2(v[10], v[11]); o1.z = pk2(v[12], v[13]); o1.w = pk2(v[14], v[15]);
        v4u* dst = (v4u*)(BtY + (size_t)n * KY + 512 + ch * 16); dst[0] = o0; dst[1] = o1;
    }
    __syncthreads();
}
__device__ __forceinline__ void ssm_prepB(Ctx& F, int l, int g, int part8) {
    F.tid = lt_tid(); F.lane = F.tid & 63;
    LAS float* KT = (LAS float*)F.lds;
    const int tid = F.tid;
    __syncthreads();
    const float* KTG = (const float*)(F.ws + WS_KTG) + (size_t)g * 16384;
    for (int i = tid; i < 4096; i += 512) *(LAS f32x4*)(KT + 4 * i) = *(const f32x4*)(KTG + 4 * i);
    __syncthreads();
    bf16* BtY = (bf16*)(F.ws + WS_BTY) + (size_t)g * 512 * KY;
    const float* dsk = F.in[I_SSMD] + l * 512 + g * 16;
    for (int task = tid; task < 64 * 32; task += 512) {
        const int n = part8 * 64 + (task >> 5), s = task & 31, t = n >> 4, hh = n & 15;
        float v[16];
#pragma unroll
        for (int h = 0; h < 16; ++h) { float x = 0.f; if (s <= t) x += KT[KTI(0, t - s, hh, h)]; if (s >= t) x += KT[KTI(1, s - t, hh, h)]; if (s == t && h == hh) x += dsk[hh]; v[h] = x; }
        v4u o0, o1; o0.x = pk2(v[0], v[1]); o0.y = pk2(v[2], v[3]); o0.z = pk2(v[4], v[5]); o0.w = pk2(v[6], v[7]); o1.x = pk2(v[8], v[9]); o1.y = pk2(v[10], v[11]); o1.z = pk2(v[12], v[13]); o1.w = pk2(v[14], v[15]);
        v4u* dst = (v4u*)(BtY + (size_t)n * KY + s * 16); dst[0] = o0; dst[1] = o1;
    }
    __syncthreads();
}
#undef CCI
#undef KTI

__device__ __forceinline__ void moe_seg(const unsigned* cnt, int (&segp)[9]) {
    int acc = 0;
#pragma unroll
    for (int e = 0; e < 8; ++e) { segp[e] = acc; acc += ((int)cnt[e] + 255) >> 8; }
    segp[8] = acc;
}
template <int MODE>
__device__ __forceinline__ void norm_phase(Ctx& F, int l, int M, bool src_in, bool combine, bool router, const float* slab_gate, int nparts) {
    F.tid = lt_tid(); F.lane = F.tid & 63;
    const int gw = F.vcu * 8 + F.wave, NGW = F.G * 8, lane = F.lane;
    float* X = (float*)(F.ws + WS_X); bf16* HB = (bf16*)(F.ws + WS_HB);
    const float* mod = (const float*)(F.ws + WS_MOD);
    const float* gain = MODE == 0 ? F.in[I_GMIX] + l * 1024 : (MODE == 1 ? F.in[I_GFFN] + l * 1024 : F.in[I_GFINAL]);
    const int* route_e = (const int*)(F.ws + WS_ROUTE); const f32x2* route_g = (const f32x2*)(F.ws + WS_ROUTE + 256 * 1024); const int* slot_of = (const int*)(F.ws + WS_ROUTE + 576 * 1024);
    int* route_e_w = (int*)(F.ws + WS_ROUTE); f32x2* route_g_w = (f32x2*)(F.ws + WS_ROUTE + 256 * 1024);
    const bf16* YS = (const bf16*)(F.ws + WS_YS); const bf16* YS2 = (const bf16*)(F.ws + WS_SLAB);
    int m2_pm0 = -1;
    if (combine && MK_SPLIT_M2) { int segp_[9]; moe_seg((const unsigned*)F.ctl + CW_CNT + ((l - 1) >> 1) * 16, segp_); const int P_ = segp_[8], Pm_ = (P_ >> 6) << 6, xl_ = P_ - Pm_; if (xl_ > 0 && xl_ <= 32 && F.G == 256) m2_pm0 = Pm_; }
    LAS int* lcnt = (LAS int*)(F.lds);
    float rw[4][4][8];
    if (router) {
        if (F.tid < 8) lcnt[F.tid] = 0;
        __syncthreads();
        const float* R = F.in[I_ROUTER] + (size_t)(l >> 1) * 1024 * 8;
#pragma unroll
        for (int j = 0; j < 4; ++j)
#pragma unroll
            for (int i = 0; i < 4; ++i) { const f32x4 a = *(const f32x4*)(R + (size_t)(256 * j + 4 * lane + i) * 8), b = *(const f32x4*)(R + (size_t)(256 * j + 4 * lane + i) * 8 + 4);
                rw[j][i][0] = a[0]; rw[j][i][1] = a[1]; rw[j][i][2] = a[2]; rw[j][i][3] = a[3]; rw[j][i][4] = b[0]; rw[j][i][5] = b[1]; rw[j][i][6] = b[2]; rw[j][i][7] = b[3]; }
    }
    f32x4 vn[4]; int s0n = 0, s1n = 0; f32x2 ggn = (f32x2){0.f, 0.f};
#pragma unroll
    for (int j = 0; j < 4; ++j) vn[j] = (f32x4){0.f, 0.f, 0.f, 0.f};
#define NORM_PREFETCH(mm) do { const int m_ = (mm); if (m_ < M) { \
        const float* srow_ = src_in ? (m_ < MLAT ? F.in[I_X] + (size_t)m_ * 1024 : F.in[I_CTX] + (size_t)(m_ - MLAT) * 1024) : X + (size_t)m_ * 1024; \
        _Pragma("unroll") for (int j = 0; j < 4; ++j) vn[j] = *(const f32x4*)(srow_ + 256 * j + 4 * lane); \
        if (combine) { s0n = slot_of[2 * m_]; s1n = slot_of[2 * m_ + 1]; ggn = route_g[m_]; } } } while (0)
    NORM_PREFETCH(gw);
    for (int m = gw; m < M; m += NGW) {
        const int bs = batch_slot(m);
        f32x4 v[4];
#pragma unroll
        for (int j = 0; j < 4; ++j) v[j] = vn[j];
        const int s0 = s0n, s1 = s1n; const f32x2 gg = ggn;
        v2u y0r[4], y1r[4];
        v2u y0b[4], y1b[4]; bool sp0 = false, sp1 = false;
        if (combine) {
#pragma unroll
            for (int j = 0; j < 4; ++j) { y0r[j] = *(const v2u*)(YS + (size_t)s0 * 1024 + 256 * j + 4 * lane); y1r[j] = *(const v2u*)(YS + (size_t)s1 * 1024 + 256 * j + 4 * lane); }
            sp0 = m2_pm0 >= 0 && (s0 >> 8) >= m2_pm0; sp1 = m2_pm0 >= 0 && (s1 >> 8) >= m2_pm0;
            if (sp0) {
#pragma unroll
                for (int j = 0; j < 4; ++j) y0b[j] = *(const v2u*)(YS2 + (size_t)(((s0 >> 8) - m2_pm0) * 4 + j) * 65536 + (size_t)(s0 & 255) * 256 + 4 * lane);
            }
            if (sp1) {
#pragma unroll
                for (int j = 0; j < 4; ++j) y1b[j] = *(const v2u*)(YS2 + (size_t)(((s1 >> 8) - m2_pm0) * 4 + j) * 65536 + (size_t)(s1 & 255) * 256 + 4 * lane);
            }
        }
        NORM_PREFETCH(m + NGW);
        if (combine) {
            const float* gt2 = mod + ((size_t)(l - 1) * 9 + bs) * 6144 + 5 * 1024;
#pragma unroll
            for (int j = 0; j < 4; ++j) { const v2u y0 = y0r[j], y1 = y1r[j];
                const f32x4 gt = *(const f32x4*)(gt2 + 256 * j + 4 * lane);
                f32x4 f; f[0] = gg[0] * bflo(y0.x) + gg[1] * bflo(y1.x); f[1] = gg[0] * bfhi(y0.x) + gg[1] * bfhi(y1.x); f[2] = gg[0] * bflo(y0.y) + gg[1] * bflo(y1.y); f[3] = gg[0] * bfhi(y0.y) + gg[1] * bfhi(y1.y);
                if (sp0) { f[0] += gg[0] * bflo(y0b[j].x); f[1] += gg[0] * bfhi(y0b[j].x); f[2] += gg[0] * bflo(y0b[j].y); f[3] += gg[0] * bfhi(y0b[j].y); }
                if (sp1) { f[0] += gg[1] * bflo(y1b[j].x); f[1] += gg[1] * bfhi(y1b[j].x); f[2] += gg[1] * bflo(y1b[j].y); f[3] += gg[1] * bfhi(y1b[j].y); }
                v[j] = v[j] + gt * f; }
        }
        const bool addslab = slab_gate != nullptr && m >= MLAT;
        if (addslab) {
            const float* sl = (const float*)(F.ws + WS_SLAB) + (size_t)(m - MLAT) * 1024;
#pragma unroll
            for (int j = 0; j < 4; ++j) { f32x4 a = *(const f32x4*)(sl + 256 * j + 4 * lane);
                for (int p = 1; p < nparts; ++p) a = a + *(const f32x4*)(sl + (size_t)p * MCTX * 1024 + 256 * j + 4 * lane);
                v[j] = v[j] + *(const f32x4*)(slab_gate + 256 * j + 4 * lane) * a; }
        }
        if (src_in || combine || addslab) {
#pragma unroll
            for (int j = 0; j < 4; ++j) *(f32x4*)(X + (size_t)m * 1024 + 256 * j + 4 * lane) = v[j];
        }
        float ss = 0.f;
#pragma unroll
        for (int j = 0; j < 4; ++j) ss += (v[j][0] * v[j][0] + v[j][1] * v[j][1]) + (v[j][2] * v[j][2] + v[j][3] * v[j][3]);
        const float rstd = 1.0f / sqrtf(wave_sum(ss) * (1.0f / 1024.0f) + NORM_EPS);
        if (MODE == 2) {
#pragma unroll
            for (int j = 0; j < 4; ++j) { const f32x4 gv = *(const f32x4*)(gain + 256 * j + 4 * lane); *(f32x4*)(F.out + (size_t)m * 1024 + 256 * j + 4 * lane) = v[j] * rstd * gv; }
        } else {
            const float* mb = mod + ((size_t)l * 9 + bs) * 6144 + (MODE == 0 ? 0 : 3 * 1024);
            float lg[8];
#pragma unroll
            for (int e = 0; e < 8; ++e) lg[e] = 0.f;
#pragma unroll
            for (int j = 0; j < 4; ++j) { const f32x4 gv = *(const f32x4*)(gain + 256 * j + 4 * lane), sh = *(const f32x4*)(mb + 256 * j + 4 * lane), sc = *(const f32x4*)(mb + 1024 + 256 * j + 4 * lane);
                const f32x4 o = v[j] * rstd * gv * (sc + 1.0f) + sh;
                v2u w; w.x = pk2(o[0], o[1]); w.y = pk2(o[2], o[3]);
                *(v2u*)(HB + (size_t)m * 1024 + 256 * j + 4 * lane) = w;
                if (router) {
#pragma unroll
                    for (int i = 0; i < 4; ++i)
#pragma unroll
                        for (int e = 0; e < 8; ++e) lg[e] += o[i] * rw[j][i][e];
                }
            }
            if (router) {
                {
                    float a4[4], a2[2], a1;
                    { const bool hi = (lane & 1) != 0;
#pragma unroll
                      for (int e = 0; e < 4; ++e) { const float snd = hi ? lg[e] : lg[e + 4], keep = hi ? lg[e + 4] : lg[e]; a4[e] = keep + __shfl_xor(snd, 1); } }
                    { const bool hi = (lane & 2) != 0;
#pragma unroll
                      for (int e = 0; e < 2; ++e) { const float snd = hi ? a4[e] : a4[e + 2], keep = hi ? a4[e + 2] : a4[e]; a2[e] = keep + __shfl_xor(snd, 2); } }
                    { const bool hi = (lane & 4) != 0; const float snd = hi ? a2[0] : a2[1], keep = hi ? a2[1] : a2[0]; a1 = keep + __shfl_xor(snd, 4); }
                    a1 += __shfl_xor(a1, 8); a1 += __shfl_xor(a1, 16); a1 += __shfl_xor(a1, 32);
#pragma unroll
                    for (int e = 0; e < 8; ++e) lg[e] = __builtin_bit_cast(float, __builtin_amdgcn_readlane(__builtin_bit_cast(int, a1), ((e >> 2) & 1) | (((e >> 1) & 1) << 1) | ((e & 1) << 2)));
                }
                int e0 = 0; float v0 = lg[0];
#pragma unroll
                for (int e = 1; e < 8; ++e) if (lg[e] > v0) { v0 = lg[e]; e0 = e; }
                int e1 = -1; float v1 = -3.0e38f;
#pragma unroll
                for (int e = 0; e < 8; ++e) if (e != e0 && lg[e] > v1) { v1 = lg[e]; e1 = e; }
                const float g0 = 1.0f / (1.0f + __expf(v1 - v0));
                if (lane == 0) { route_e_w[m] = e0 | (e1 << 8); route_g_w[m] = (f32x2){g0, 1.0f - g0}; __hip_atomic_fetch_add(&lcnt[e0], 1, __ATOMIC_RELAXED, __HIP_MEMORY_SCOPE_WORKGROUP); __hip_atomic_fetch_add(&lcnt[e1], 1, __ATOMIC_RELAXED, __HIP_MEMORY_SCOPE_WORKGROUP);
                    gu32* bc_ = F.ctl + CW_BCNT + ((l >> 1) * 256 + m / (M / F.G)) * 8; (void)__hip_atomic_fetch_add(bc_ + e0, 1u, RLX_AGENT); (void)__hip_atomic_fetch_add(bc_ + e1, 1u, RLX_AGENT); }
            }
        }
    }
#undef NORM_PREFETCH
    if (router) {
        __syncthreads();
        if (F.tid < 8) atomicAdd((unsigned*)F.ctl + CW_CNT + (l >> 1) * 16 + F.tid, (unsigned)lcnt[F.tid]);
    }
    (void)route_e;
}

__device__ __forceinline__ int carry_cr(int dir, int b, int k) {
    if (dir == 0) return k < 8 ? 1024 + b * 8 + k : b * 128 + (k - 8);
    return k < 8 ? 1024 + b * 8 + (7 - k) : b * 128 + 127 - (k - 8);
}
__device__ __forceinline__ void carry_phase(Ctx& F, int l) {
    F.tid = lt_tid(); F.lane = F.tid & 63;
    LAS float* EX = (LAS float*)F.lds;
    for (int it = F.vcu; it < 256; it += F.G) {
        const int b = it >> 5, g = it & 31;
        const int p = F.tid & 63, dir = (F.tid >> 6) & 1, seg = F.tid >> 7;
        const int pi = ((l * 2 + dir) * 32 + g) * 64 + p;
        const float are = fminf(F.in[I_ARE][pi], -1e-4f), aim = F.in[I_AIM][pi];
        const float dt = __expf(F.in[I_LOGSTEP][(l * 2 + dir) * 32 + g]);
        float s32, c32; sincos_red(aim * dt * 32.0f, s32, c32); const float m32 = __expf(are * dt * 32.0f);
        const float Lr = m32 * c32, Li = m32 * s32;
        const float* S = (const float*)(F.ws + WS_S) + (size_t)g * NCRP * 256 + dir * 128 + p;
        bf16* AY = (bf16*)(F.ws + WS_AY) + (size_t)g * NCRP * KY + 512 + dir * 128 + p;
        float sr[34], si[34];
#pragma unroll
        for (int i = 0; i < 34; ++i) { const int cr = carry_cr(dir, b, seg * 34 + i); sr[i] = S[(size_t)cr * 256]; si[i] = S[(size_t)cr * 256 + 64]; }
        float hr = 0.f, hi = 0.f, pr = 1.f, pim = 0.f;
#pragma unroll
        for (int i = 0; i < 34; ++i) { const float nr = Lr * hr - Li * hi + sr[i], ni = Lr * hi + Li * hr + si[i]; hr = nr; hi = ni; const float qr = pr * Lr - pim * Li, qi = pr * Li + pim * Lr; pr = qr; pim = qi; }
        __syncthreads();
        EX[(seg * 128 + (F.tid & 127)) * 2] = hr; EX[(seg * 128 + (F.tid & 127)) * 2 + 1] = hi;
        __syncthreads();
        float h0r = 0.f, h0i = 0.f;
        for (int j = 0; j < seg; ++j) { const float er = EX[(j * 128 + (F.tid & 127)) * 2], ei = EX[(j * 128 + (F.tid & 127)) * 2 + 1];
            const float nr = pr * h0r - pim * h0i + er, ni = pr * h0i + pim * h0r + ei; h0r = nr; h0i = ni; }
        hr = h0r; hi = h0i;
#pragma unroll
        for (int i = 0; i < 34; ++i) { const int cr = carry_cr(dir, b, seg * 34 + i);
            AY[(size_t)cr * KY] = (bf16)f2bf(hr); AY[(size_t)cr * KY + 64] = (bf16)f2bf(hi);
            const float nr = Lr * hr - Li * hi + sr[i], ni = Lr * hi + Li * hr + si[i]; hr = nr; hi = ni; }
    }
}

constexpr int SI_HP = 528, SI_AP = 272, SI_H_OFF = 0, SI_A_OFF = 144 * SI_HP, SI_EX_OFF = SI_A_OFF + 144 * SI_AP;
static_assert(SI_EX_OFF + 4 * 128 * 8 <= LDSCTL_OFF, "ssm item LDS map");
__device__ __forceinline__ int si_cr(int b, int r) { return r < 8 ? 1024 + 8 * b + r : 128 * b + r - 8; }
__device__ __forceinline__ void ssm_item(Ctx& F, int l, int b, int g, bool last) {
    F.tid = lt_tid(); F.lane = F.tid & 63;
    const int tid = F.tid, w = lt_s(F.wave), lane = F.lane, fr = lane & 15, fq = lane >> 4;
    LAS unsigned char* Hb = F.lds + SI_H_OFF; LAS unsigned char* Ab = F.lds + SI_A_OFF; LAS float* EX = (LAS float*)(F.lds + SI_EX_OFF);
    const bf16* AY = (const bf16*)(F.ws + WS_AY) + (size_t)g * NCRP * KY;
    const bf16* BtS = (const bf16*)(F.ws + WS_BTS) + (size_t)g * 256 * 512;
    const bf16* BtY = (const bf16*)(F.ws + WS_BTY) + (size_t)g * 512 * KY;
    __syncthreads();
    for (int i = tid; i < 8 * SI_AP / 4; i += 512) ((LAS unsigned*)(Ab + 136 * SI_AP))[i] = 0u;
#define SI_PREF(kc) do { _Pragma("unroll") for (int ps = 0; ps < 5; ++ps) { const int row = ps * 32 + (tid >> 4); if (row < 136) \
        pre[ps] = *(const v4u*)(AY + (size_t)si_cr(b, row) * KY + (kc) * 128 + (tid & 15) * 8); } } while (0)
#define SI_COMMIT() do { _Pragma("unroll") for (int ps = 0; ps < 5; ++ps) { const int row = ps * 32 + (tid >> 4); if (row < 136) \
        *(LAS v4u*)(Ab + row * SI_AP + (tid & 15) * 16) = pre[ps]; } } while (0)
#define SI_STAGE(kc) do { _Pragma("unroll") for (int ps = 0; ps < 5; ++ps) { const int row = ps * 32 + (tid >> 4); if (row < 136) \
        *(LAS v4u*)(Ab + row * SI_AP + (tid & 15) * 16) = *(const v4u*)(AY + (size_t)si_cr(b, row) * KY + (kc) * 128 + (tid & 15) * 8); } } while (0)
    v4u pre[5];
#pragma unroll
    for (int ps = 0; ps < 5; ++ps) pre[ps] = (v4u){0u, 0u, 0u, 0u};
    {
        f32x4 acc[2][9];
#pragma unroll
        for (int t = 0; t < 2; ++t)
#pragma unroll
            for (int mt = 0; mt < 9; ++mt) acc[t][mt] = (f32x4){0.f, 0.f, 0.f, 0.f};
        const bf16* bp = BtS + (size_t)(32 * w + fr) * 512 + 8 * fq;
        bf16x8 bw[2][4][2];
#pragma unroll
        for (int k4 = 0; k4 < 4; ++k4)
#pragma unroll
            for (int t = 0; t < 2; ++t) bw[0][k4][t] = *(const bf16x8*)(bp + (size_t)(16 * t) * 512 + 32 * k4);
        SI_PREF(0);
#pragma unroll
        for (int kc = 0; kc < 4; ++kc) {
            SI_COMMIT();
            __syncthreads();
            if (kc + 1 < 4) SI_PREF(kc + 1); else SI_PREF(0);
            if (kc + 1 < 4) {
#pragma unroll
                for (int k4 = 0; k4 < 4; ++k4)
#pragma unroll
                    for (int t = 0; t < 2; ++t) bw[(kc + 1) & 1][k4][t] = *(const bf16x8*)(bp + (size_t)(16 * t) * 512 + 32 * (4 * (kc + 1) + k4));
            }
#pragma unroll
            for (int k4 = 0; k4 < 4; ++k4) {
#pragma unroll
                for (int mt = 0; mt < 9; ++mt) { const bf16x8 af = *(const LAS bf16x8*)(Ab + (16 * mt + fr) * SI_AP + (32 * k4 + 8 * fq) * 2);
#pragma unroll
                    for (int t = 0; t < 2; ++t) acc[t][mt] = __builtin_amdgcn_mfma_f32_16x16x32_bf16(bw[kc & 1][k4][t], af, acc[t][mt], 0, 0, 0); }
            }
            __syncthreads();
        }
#pragma unroll
        for (int t = 0; t < 2; ++t)
#pragma unroll
            for (int mt = 0; mt < 9; ++mt) { v2u o; o.x = cvt_pk_bf16(acc[t][mt][0], acc[t][mt][1]); o.y = cvt_pk_bf16(acc[t][mt][2], acc[t][mt][3]);
                *(LAS v2u*)(Hb + (16 * mt + fr) * SI_HP + (32 * w + 16 * t + 4 * fq) * 2) = o; }
    }
    __syncthreads();
    {
        const int p = tid & 63, dir = (tid >> 6) & 1, seg = tid >> 7;
        const int pi = ((l * 2 + dir) * 32 + g) * 64 + p;
        const float are = fminf(F.in[I_ARE][pi], -1e-4f), aim = F.in[I_AIM][pi];
        const float dt = __expf(F.in[I_LOGSTEP][(l * 2 + dir) * 32 + g]);
        float s32, c32; sincos_red(aim * dt * 32.0f, s32, c32); const float m32 = __expf(are * dt * 32.0f);
        const float Lr = m32 * c32, Li = m32 * s32;
        LAS unsigned short* col = (LAS unsigned short*)(Hb + (dir * 128 + p) * 2);
        float sr[34], si[34];
#pragma unroll
        for (int i = 0; i < 34; ++i) { const int k = seg * 34 + i; const int r = dir ? (k < 8 ? 7 - k : 143 - k) : k;
            sr[i] = bf2f(col[r * (SI_HP / 2)]); si[i] = bf2f(col[r * (SI_HP / 2) + 64]); }
        float hr = 0.f, hi = 0.f, pr = 1.f, pim = 0.f;
#pragma unroll
        for (int i = 0; i < 34; ++i) { const float nr = Lr * hr - Li * hi + sr[i], ni = Lr * hi + Li * hr + si[i]; hr = nr; hi = ni; const float qr = pr * Lr - pim * Li, qi = pr * Li + pim * Lr; pr = qr; pim = qi; }
        EX[(seg * 128 + (tid & 127)) * 2] = hr; EX[(seg * 128 + (tid & 127)) * 2 + 1] = hi;
        __syncthreads();
        float h0r = 0.f, h0i = 0.f;
        for (int j = 0; j < seg; ++j) { const float er = EX[(j * 128 + (tid & 127)) * 2], ei = EX[(j * 128 + (tid & 127)) * 2 + 1];
            const float nr = pr * h0r - pim * h0i + er, ni = pr * h0i + pim * h0r + ei; h0r = nr; h0i = ni; }
        hr = h0r; hi = h0i;
#pragma unroll
        for (int i = 0; i < 34; ++i) { const int k = seg * 34 + i; const int r = dir ? (k < 8 ? 7 - k : 143 - k) : k;
            col[r * (SI_HP / 2)] = (unsigned short)f2bf(hr); col[r * (SI_HP / 2) + 64] = (unsigned short)f2bf(hi);
            const float nr = Lr * hr - Li * hi + sr[i], ni = Lr * hi + Li * hr + si[i]; hr = nr; hi = ni; }
    }
    __syncthreads();
    for (int hp = 0; hp < 2; ++hp) {
        f32x4 acc[2][9];
#pragma unroll
        for (int t = 0; t < 2; ++t)
#pragma unroll
            for (int mt = 0; mt < 9; ++mt) acc[t][mt] = (f32x4){0.f, 0.f, 0.f, 0.f};
        const bf16* bp = BtY + (size_t)(64 * w + 32 * hp + fr) * KY + 8 * fq;
        bf16x8 bw[2][4][2];
#pragma unroll
        for (int k4 = 0; k4 < 4; ++k4)
#pragma unroll
            for (int t = 0; t < 2; ++t) bw[0][k4][t] = *(const bf16x8*)(bp + (size_t)(16 * t) * KY + 32 * k4);
#pragma unroll
        for (int kc = 0; kc < 6; ++kc) {
            if (kc < 4) { SI_COMMIT(); __syncthreads(); if (kc + 1 < 4) SI_PREF(kc + 1); }
            if (kc == 4 && hp == 0) SI_PREF(0);
            if (kc + 1 < 6) {
#pragma unroll
                for (int k4 = 0; k4 < 4; ++k4)
#pragma unroll
                    for (int t = 0; t < 2; ++t) bw[(kc + 1) & 1][k4][t] = *(const bf16x8*)(bp + (size_t)(16 * t) * KY + 32 * (4 * (kc + 1) + k4));
            }
            const LAS unsigned char* abase = kc < 4 ? (const LAS unsigned char*)Ab : (const LAS unsigned char*)(Hb + (kc - 4) * 256);
            const int apitch = kc < 4 ? SI_AP : SI_HP;
#pragma unroll
            for (int k4 = 0; k4 < 4; ++k4) {
#pragma unroll
                for (int mt = 0; mt < 9; ++mt) { const bf16x8 af = *(const LAS bf16x8*)(abase + (16 * mt + fr) * apitch + (32 * k4 + 8 * fq) * 2);
#pragma unroll
                    for (int t = 0; t < 2; ++t) acc[t][mt] = __builtin_amdgcn_mfma_f32_16x16x32_bf16(bw[kc & 1][k4][t], af, acc[t][mt], 0, 0, 0); }
            }
            if (kc < 4) __syncthreads();
        }
        bf16* G = (bf16*)(F.ws + WS_G);
#pragma unroll
        for (int mt = 0; mt < 9; ++mt) { const int r = 16 * mt + fr;
            if (r < 136 && !(last && r < 8)) {
                const size_t tok0 = (size_t)si_cr(b, r) * 32;
#pragma unroll
                for (int t = 0; t < 2; ++t) { v2u o; o.x = cvt_pk_bf16(gelu_tanh(acc[t][mt][0]), gelu_tanh(acc[t][mt][1])); o.y = cvt_pk_bf16(gelu_tanh(acc[t][mt][2]), gelu_tanh(acc[t][mt][3]));
                    *(v2u*)(G + (tok0 + 4 * w + 2 * hp + t) * 512 + g * 16 + 4 * fq) = o; }
            }
        }
    }
#undef SI_STAGE
#undef SI_PREF
#undef SI_COMMIT
    __syncthreads();
}

constexpr int KS_STRIDE = 144, VT_STRIDE = 144, KS_SLOT = 64 * KS_STRIDE, VT_SLOT = 64 * VT_STRIDE;
typedef short v4i16_t __attribute__((ext_vector_type(4)));
template <int NKB, bool LAT>
__device__ __forceinline__ void attn_tile(const LAS unsigned char* Ks, const LAS unsigned char* Vt, int kbase, const bf16x8 (&qf)[2], f32x4 (&O)[4], float& mrun, float& lrun,
                                          int fr, int fq, const LAS float* biasrow, int qc, int cs) {
    f32x4 st[2 * NKB];
#pragma unroll
    for (int kt = 0; kt < 2 * NKB; ++kt) {
        st[kt] = (f32x4){0.f, 0.f, 0.f, 0.f};
#pragma unroll
        for (int ks = 0; ks < 2; ++ks) { const bf16x8 kf = *(const LAS bf16x8*)(Ks + (kbase + 16 * kt + fr) * KS_STRIDE + (8 * fq + 32 * ks) * 2);
            st[kt] = __builtin_amdgcn_mfma_f32_16x16x32_bf16(kf, qf[ks], st[kt], 0, 0, 0); }
    }
    float tmax = -3.0e38f;
#pragma unroll
    for (int kt = 0; kt < 2 * NKB; ++kt)
#pragma unroll
        for (int i = 0; i < 4; ++i) {
            if (LAT) { const int kc = kbase + 16 * kt + 4 * fq + i; const bool ok = (kc >= cs) && (kc < cs + 16);
                const float bv = biasrow[ok ? (kc - qc + 15) : 0];
                st[kt][i] = ok ? st[kt][i] + bv : -__builtin_inff(); }
            tmax = fmaxf(tmax, st[kt][i]);
        }
    tmax = fmaxf(tmax, __shfl_xor(tmax, 16)); tmax = fmaxf(tmax, __shfl_xor(tmax, 32));
    const float mnew = fmaxf(mrun, tmax), alpha = __builtin_amdgcn_exp2f(mrun - mnew);
    float ps = 0.f;
#pragma unroll
    for (int kt = 0; kt < 2 * NKB; ++kt)
#pragma unroll
        for (int i = 0; i < 4; ++i) { const float pv = __builtin_amdgcn_exp2f(st[kt][i] - mnew); st[kt][i] = pv; ps += pv; }
    lrun = lrun * alpha + ps; mrun = mnew;
#pragma unroll
    for (int dt = 0; dt < 4; ++dt) O[dt] = O[dt] * alpha;
#pragma unroll
    for (int kb = 0; kb < NKB; ++kb) {
        union { bf16x8 v; unsigned u[4]; } pf;
        pf.u[0] = cvt_pk_bf16(st[2 * kb][0], st[2 * kb][1]); pf.u[1] = cvt_pk_bf16(st[2 * kb][2], st[2 * kb][3]);
        pf.u[2] = cvt_pk_bf16(st[2 * kb + 1][0], st[2 * kb + 1][1]); pf.u[3] = cvt_pk_bf16(st[2 * kb + 1][2], st[2 * kb + 1][3]);
#pragma unroll
        for (int dt = 0; dt < 4; ++dt) {
            union { bf16x8 v; v4i16_t t[2]; } vf;
            const LAS unsigned char* vp = Vt + (kbase + 32 * kb + 4 * fq + (fr >> 2)) * VT_STRIDE + (16 * dt + 4 * (fr & 3)) * 2;
            vf.t[0] = __builtin_amdgcn_ds_read_tr16_b64_v4i16((LAS v4i16_t*)vp); vf.t[1] = __builtin_amdgcn_ds_read_tr16_b64_v4i16((LAS v4i16_t*)(vp + 16 * VT_STRIDE));
            O[dt] = __builtin_amdgcn_mfma_f32_16x16x32_bf16(vf.v, pf.v, O[dt], 0, 0, 0);
        }
    }
}
__device__ __forceinline__ float xl_max4(float x) {
    unsigned u = __builtin_bit_cast(unsigned, x); auto a = __builtin_amdgcn_permlane16_swap(u, u, false, false);
    const float m = fmaxf(__builtin_bit_cast(float, a[0]), __builtin_bit_cast(float, a[1]));
    u = __builtin_bit_cast(unsigned, m); auto b = __builtin_amdgcn_permlane32_swap(u, u, false, false);
    return fmaxf(__builtin_bit_cast(float, b[0]), __builtin_bit_cast(float, b[1]));
}
template <bool LAT>
__device__ __forceinline__ void attn_stage(const LAS unsigned char* stg, int cnt, int tile_b, const bf16x8 (&qf)[2], f32x4 (&O)[4], float& mrun, float& lrun,
                                           int fr, int fq, int kbase, const LAS float* bias_s, int kr0, int my_rs, int qrow, int qc, int cs) {
    constexpr int NKT = LAT ? 2 : 4, NKB = NKT / 2;
    f32x4 st[4][NKT];
#pragma unroll
    for (int j = 0; j < 4; ++j) {
        const bool rv = LAT ? (j < cnt && (kr0 + j) >= my_rs && (kr0 + j) < my_rs + 8) : true;
        if (rv) {
            const LAS unsigned char* Ks = stg + j * tile_b;
#pragma unroll
            for (int kt = 0; kt < NKT; ++kt) {
                st[j][kt] = (f32x4){0.f, 0.f, 0.f, 0.f};
#pragma unroll
                for (int ks = 0; ks < 2; ++ks) { const bf16x8 kf = *(const LAS bf16x8*)(Ks + (kbase + 16 * kt + fr) * KS_STRIDE + (8 * fq + 32 * ks) * 2);
                    st[j][kt] = __builtin_amdgcn_mfma_f32_16x16x32_bf16(kf, qf[ks], st[j][kt], 0, 0, 0); }
            }
        } else {
#pragma unroll
            for (int kt = 0; kt < NKT; ++kt) st[j][kt] = (f32x4){0.f, 0.f, 0.f, 0.f};
        }
    }
    float tmax = -3.0e38f;
    if (LAT) {
        float bv[4][NKT][4];
#pragma unroll
        for (int j = 0; j < 4; ++j) { const int rrel = min(max(kr0 + j - qrow + 7, 0), 14);
#pragma unroll
            for (int kt = 0; kt < NKT; ++kt)
#pragma unroll
                for (int i = 0; i < 4; ++i) { const int kc = kbase + 16 * kt + 4 * fq + i; bv[j][kt][i] = bias_s[rrel * 31 + min(max(kc - qc + 15, 0), 30)]; } }
#pragma unroll
        for (int j = 0; j < 4; ++j) { const bool rv = (j < cnt && (kr0 + j) >= my_rs && (kr0 + j) < my_rs + 8);
#pragma unroll
            for (int kt = 0; kt < NKT; ++kt)
#pragma unroll
                for (int i = 0; i < 4; ++i) { const int kc = kbase + 16 * kt + 4 * fq + i; const bool ok = rv && (kc >= cs) && (kc < cs + 16);
                    st[j][kt][i] = ok ? st[j][kt][i] + bv[j][kt][i] : -__builtin_inff(); tmax = fmaxf(tmax, st[j][kt][i]); } }
    } else {
#pragma unroll
        for (int j = 0; j < 4; ++j)
#pragma unroll
            for (int kt = 0; kt < NKT; ++kt)
#pragma unroll
                for (int i = 0; i < 4; ++i) tmax = fmaxf(tmax, st[j][kt][i]);
    }
    tmax = xl_max4(tmax);
    const float mnew = fmaxf(mrun, tmax), alpha = __builtin_amdgcn_exp2f(mrun - mnew);
    float ps = 0.f;
#pragma unroll
    for (int j = 0; j < 4; ++j)
#pragma unroll
        for (int kt = 0; kt < NKT; ++kt)
#pragma unroll
            for (int i = 0; i < 4; ++i) { const float pv = __builtin_amdgcn_exp2f(st[j][kt][i] - mnew); st[j][kt][i] = pv; ps += pv; }
    lrun = lrun * alpha + ps; mrun = mnew;
#pragma unroll
    for (int dt = 0; dt < 4; ++dt) O[dt] = O[dt] * alpha;
#pragma unroll
    for (int j = 0; j < 4; ++j) {
        const bool rv = LAT ? (j < cnt && (kr0 + j) >= my_rs && (kr0 + j) < my_rs + 8) : true;
        if (rv) {
            const LAS unsigned char* Vt = stg + j * tile_b + KS_SLOT;
#pragma unroll
            for (int kb = 0; kb < NKB; ++kb) {
                union { bf16x8 v; unsigned u[4]; } pf;
                pf.u[0] = cvt_pk_bf16(st[j][2 * kb][0], st[j][2 * kb][1]); pf.u[1] = cvt_pk_bf16(st[j][2 * kb][2], st[j][2 * kb][3]);
                pf.u[2] = cvt_pk_bf16(st[j][2 * kb + 1][0], st[j][2 * kb + 1][1]); pf.u[3] = cvt_pk_bf16(st[j][2 * kb + 1][2], st[j][2 * kb + 1][3]);
#pragma unroll
                for (int dt = 0; dt < 4; ++dt) {
                    union { bf16x8 v; v4i16_t t[2]; } vf;
                    const LAS unsigned char* vp = Vt + (kbase + 32 * kb + 4 * fq + (fr >> 2)) * VT_STRIDE + (16 * dt + 4 * (fr & 3)) * 2;
                    vf.t[0] = __builtin_amdgcn_ds_read_tr16_b64_v4i16((LAS v4i16_t*)vp); vf.t[1] = __builtin_amdgcn_ds_read_tr16_b64_v4i16((LAS v4i16_t*)(vp + 16 * VT_STRIDE));
                    O[dt] = __builtin_amdgcn_mfma_f32_16x16x32_bf16(vf.v, pf.v, O[dt], 0, 0, 0);
                }
            }
        }
    }
}
constexpr int ATT_TG = 4, ATT_TILE_B = KS_SLOT + VT_SLOT, ATT_STAGE_B = ATT_TG * ATT_TILE_B, ATT_BIAS2_OFF = LDSCTL_OFF + 1024, ATT_BIAS_B = 1920;
static_assert(2 * ATT_STAGE_B <= LDSCTL_OFF && ATT_BIAS2_OFF + 2 * ATT_BIAS_B <= LDS_BYTES, "attention LDS map");
struct AttItem { int b, h, rp, rsA, rsB, ntile, nstage; };
__device__ __forceinline__ AttItem att_dec(int it) { AttItem a; a.b = it >> 8; a.h = (it >> 5) & 7; a.rp = it & 31; a.rsA = min(max(2 * a.rp - 4, 0), 56); a.rsB = min(max(2 * a.rp - 3, 0), 56);
    a.ntile = a.rsB + 8 - a.rsA + 4; a.nstage = (a.ntile + ATT_TG - 1) / ATT_TG; return a; }
__device__ __forceinline__ void attn_phase(Ctx& F, int l, bool do_ctx, int it0, int nit, int stride) {
    F.tid = lt_tid(); F.lane = F.tid & 63;
    LAS unsigned char* lds = F.lds;
    const bf16* Qb = (const bf16*)(F.ws + WS_Q); const bf16* Kb = (const bf16*)(F.ws + WS_K); const bf16* Vb = (const bf16*)(F.ws + WS_V);
    bf16* YA = (bf16*)(F.ws + WS_YA);
    const int tid = F.tid, w = lt_s(F.wave), lane = F.lane, fr = lane & 15, fq = lane >> 4;
    const int lkey = tid >> 3, lch = tid & 7, ct = w & 3, qc = 16 * ct + fr;
    const int wsc = min(max(16 * ct - 8, 0), 32), cs = min(max(qc - 8, 0), 48);
    const float* rpb = F.in[I_RPB] + (size_t)l * 8 * 465;
    {
        int lit = it0, lst = 0, lpar = 0, lrem = nit; bool lvalid = lrem > 0; AttItem LI = att_dec(lvalid ? lit : 0);
        int cit = it0, cst = 0, cpar = 0, crem = nit; AttItem CI = att_dec(crem > 0 ? cit : 0);
        v4u k0r[ATT_TG], v0r[ATT_TG], k1r[ATT_TG], v1r[ATT_TG]; float bias0 = 0.f, bias1 = 0.f; int cnt0 = 0, cnt1 = 0, fst0 = 0, fst1 = 0;
        bf16x8 qn[2], qf[2]; f32x4 O[4]; float mrun = -1.0e30f, lrun = 0.f; int qrow = 0, my_rs = 0, tokq = 0;
        qn[0] = (bf16x8){0,0,0,0,0,0,0,0}; qn[1] = qn[0]; qf[0] = qn[0]; qf[1] = qn[0];
#pragma unroll
        for (int dt = 0; dt < 4; ++dt) O[dt] = (f32x4){0.f, 0.f, 0.f, 0.f};
#define ATT_LD(KR, VR, BIASR, CNT, FST) do { CNT = 0; FST = 0; if (lvalid) { CNT = min(ATT_TG, LI.ntile - ATT_TG * lst); FST = (lst == 0) ? (1 + lpar) : 0; \
            const size_t hoff = (size_t)LI.h * 64 + 8 * lch; \
            _Pragma("unroll") for (int j = 0; j < ATT_TG; ++j) if (j < CNT) { const int t = lst * ATT_TG + j; \
                const int tokk = (t < 4 ? MLAT + LI.b * 256 + 64 * t : LI.b * 4096 + (LI.rsA + t - 4) * 64) + lkey; \
                KR[j] = *(const v4u*)(Kb + (size_t)tokk * 512 + hoff); VR[j] = *(const v4u*)(Vb + (size_t)tokk * 512 + hoff); } \
            if (lst == 0) { BIASR = tid < 465 ? rpb[LI.h * 465 + tid] * LOG2E : 0.f; \
                const int tq = LI.b * 4096 + (2 * LI.rp + (w >> 2)) * 64 + qc; \
                qn[0] = *(const bf16x8*)(Qb + (size_t)tq * 512 + LI.h * 64 + 8 * fq); qn[1] = *(const bf16x8*)(Qb + (size_t)tq * 512 + LI.h * 64 + 32 + 8 * fq); } \
            ++lst; if (lst == LI.nstage) { lit += stride; --lrem; lvalid = lrem > 0; if (lvalid) LI = att_dec(lit); lst = 0; lpar ^= 1; } } } while (0)
#define ATT_ST(KR, VR, BIASR, CNT, FST, BUF) do { \
            _Pragma("unroll") for (int j = 0; j < ATT_TG; ++j) if (j < CNT) { \
                LAS unsigned char* Ks = lds + (BUF) * ATT_STAGE_B + j * ATT_TILE_B; LAS unsigned char* Vt = Ks + KS_SLOT; \
                *(LAS v4u*)(Ks + lkey * KS_STRIDE + lch * 16) = KR[j]; *(LAS v4u*)(Vt + lkey * VT_STRIDE + lch * 16) = VR[j]; } \
            if (FST && tid < 465) ((LAS float*)(lds + ATT_BIAS2_OFF + (FST - 1) * ATT_BIAS_B))[tid] = BIASR; } while (0)
#define ATT_COMPUTE(BUF) do { \
            if (cst == 0) { qf[0] = qn[0]; qf[1] = qn[1]; mrun = -1.0e30f; lrun = 0.f; _Pragma("unroll") for (int dt = 0; dt < 4; ++dt) O[dt] = (f32x4){0.f, 0.f, 0.f, 0.f}; \
                qrow = 2 * CI.rp + (w >> 2); my_rs = (w >> 2) ? CI.rsB : CI.rsA; tokq = CI.b * 4096 + qrow * 64 + qc; } \
            const LAS float* bias_s = (const LAS float*)(lds + ATT_BIAS2_OFF + cpar * ATT_BIAS_B); \
            if (cst == 0) attn_stage<false>(lds + (BUF) * ATT_STAGE_B, 4, ATT_TILE_B, qf, O, mrun, lrun, fr, fq, 0, bias_s, 0, 0, 0, 0, 0); \
            else attn_stage<true>(lds + (BUF) * ATT_STAGE_B, min(ATT_TG, CI.ntile - ATT_TG * cst), ATT_TILE_B, qf, O, mrun, lrun, fr, fq, wsc, bias_s, CI.rsA + ATT_TG * cst - 4, my_rs, qrow, qc, cs); \
            ++cst; \
            if (cst == CI.nstage) { float ls = lrun; ls += __shfl_xor(ls, 16); ls += __shfl_xor(ls, 32); const float inv = 1.0f / ls; \
                _Pragma("unroll") for (int dt = 0; dt < 4; ++dt) { v2u o; o.x = pk2(O[dt][0] * inv, O[dt][1] * inv); o.y = pk2(O[dt][2] * inv, O[dt][3] * inv); \
                    *(v2u*)(YA + (size_t)tokq * 1024 + 512 + CI.h * 64 + 16 * dt + 4 * fq) = o; } \
                cit += stride; --crem; if (crem > 0) CI = att_dec(cit); cst = 0; cpar ^= 1; } } while (0)
        if (crem > 0) {
            __syncthreads();
            ATT_LD(k0r, v0r, bias0, cnt0, fst0);
            ATT_LD(k1r, v1r, bias1, cnt1, fst1);
            ATT_ST(k0r, v0r, bias0, cnt0, fst0, 0);
            __syncthreads();
            for (;;) {
                ATT_LD(k0r, v0r, bias0, cnt0, fst0);
                ATT_COMPUTE(0);
                if (crem <= 0) break;
                ATT_ST(k1r, v1r, bias1, cnt1, fst1, 1);
                __syncthreads();
                ATT_LD(k1r, v1r, bias1, cnt1, fst1);
                ATT_COMPUTE(1);
                if (crem <= 0) break;
                ATT_ST(k0r, v0r, bias0, cnt0, fst0, 0);
                __syncthreads();
            }
        }
#undef ATT_LD
#undef ATT_ST
#undef ATT_COMPUTE
    }
    if (do_ctx) {
        for (int it = F.vcu; it < 128; it += F.G) {
            const int b = it >> 4, h = (it >> 1) & 7, half = it & 1;
            const int tokq = MLAT + b * 256 + half * 128 + w * 16 + fr;
            const size_t hoff = (size_t)h * 64 + 8 * lch;
            v4u kreg[4], vreg[4];
#pragma unroll
            for (int j = 0; j < 4; ++j) { const int tokk = MLAT + b * 256 + 64 * j + lkey; kreg[j] = *(const v4u*)(Kb + (size_t)tokk * 512 + hoff); vreg[j] = *(const v4u*)(Vb + (size_t)tokk * 512 + hoff); }
            bf16x8 qf[2];
            qf[0] = *(const bf16x8*)(Qb + (size_t)tokq * 512 + h * 64 + 8 * fq); qf[1] = *(const bf16x8*)(Qb + (size_t)tokq * 512 + h * 64 + 32 + 8 * fq);
            __syncthreads();
#pragma unroll
            for (int j = 0; j < 4; ++j) { LAS unsigned char* Ks = lds + j * ATT_TILE_B; LAS unsigned char* Vt = Ks + KS_SLOT;
                *(LAS v4u*)(Ks + lkey * KS_STRIDE + lch * 16) = kreg[j]; *(LAS v4u*)(Vt + lkey * VT_STRIDE + lch * 16) = vreg[j]; }
            __syncthreads();
            f32x4 O[4];
#pragma unroll
            for (int dt = 0; dt < 4; ++dt) O[dt] = (f32x4){0.f, 0.f, 0.f, 0.f};
            float mrun = -1.0e30f, lrun = 0.f;
            attn_stage<false>(lds, 4, ATT_TILE_B, qf, O, mrun, lrun, fr, fq, 0, (const LAS float*)lds, 0, 0, 0, 0, 0);
            lrun += __shfl_xor(lrun, 16); lrun += __shfl_xor(lrun, 32);
            const float inv = 1.0f / lrun;
#pragma unroll
            for (int dt = 0; dt < 4; ++dt) { v2u o; o.x = pk2(O[dt][0] * inv, O[dt][1] * inv); o.y = pk2(O[dt][2] * inv, O[dt][3] * inv);
                *(v2u*)(YA + (size_t)tokq * 1024 + 512 + h * 64 + 16 * dt + 4 * fq) = o; }
        }
    }
}

__device__ __forceinline__ void scatter_phase(Ctx& F, int l, int M, int ncopy) {
    F.tid = lt_tid(); F.lane = F.tid & 63;
    LAS int* lc = (LAS int*)F.lds;
    LAS int* gb = lc + 8; LAS int* lpos = lc + 16;
    const unsigned* cnt = (const unsigned*)F.ctl + CW_CNT + (l >> 1) * 16;
    const int* route_e = (const int*)(F.ws + WS_ROUTE); int* slot_of = (int*)(F.ws + WS_ROUTE + 576 * 1024);
    const bf16* HB = (const bf16*)(F.ws + WS_HB); bf16* XS = (bf16*)(F.ws + WS_XS);
    int segp[9]; moe_seg(cnt, segp);
    const int per = M / F.G;
    const int t0 = F.vcu * per;
    LAS int* ent = lc + 16 + 512;
    if (F.tid < 8) gb[F.tid] = 0;
    __syncthreads();
    const int nent = 2 * per;
    int my_e = 0;
    if (F.tid < nent) { const int tok = t0 + (F.tid >> 1), re = route_e[tok]; my_e = (F.tid & 1) ? (re >> 8) : (re & 255); ent[F.tid] = my_e; }
    if (F.tid < F.vcu && F.tid < 256) { const unsigned* bc = (const unsigned*)F.ctl + CW_BCNT + ((l >> 1) * 256 + F.tid) * 8;
#pragma unroll
        for (int e = 0; e < 8; ++e) { const int c = (int)bc[e]; if (c) __hip_atomic_fetch_add(&gb[e], c, __ATOMIC_RELAXED, __HIP_MEMORY_SCOPE_WORKGROUP); } }
    __syncthreads();
    if (F.tid < nent) { int rank = 0; for (int j = 0; j < F.tid; ++j) rank += (ent[j] == my_e) ? 1 : 0;
        const int slot = segp[my_e] * 256 + gb[my_e] + rank; lpos[F.tid] = slot; slot_of[2 * t0 + F.tid] = slot; }
    __syncthreads();
    for (int rep_ = 0; rep_ < ncopy; ++rep_)
    for (int en = F.wave; en < nent; en += 32) {
        v4u a[4][2]; int sl[4];
#pragma unroll
        for (int q = 0; q < 4; ++q) { const int e2 = en + 8 * q; if (e2 < nent) { const int tok = t0 + (e2 >> 1); sl[q] = lpos[e2];
            const v4u* src = (const v4u*)(HB + (size_t)tok * 1024); a[q][0] = src[F.lane]; a[q][1] = src[F.lane + 64]; } }
#pragma unroll
        for (int q = 0; q < 4; ++q) { const int e2 = en + 8 * q; if (e2 < nent) { v4u* dst = (v4u*)(XS + (size_t)sl[q] * 1024); dst[F.lane] = a[q][0]; dst[F.lane + 64] = a[q][1]; } }
    }
}

constexpr int NPL = 14;
constexpr int NPHASE = 1 + DEPTH * NPL + 1;
__global__ void __launch_bounds__(512, 2) mk_fwd(Args args) {
    extern __shared__ __attribute__((aligned(16))) unsigned char lds_raw[];
    Ctx F;
    F.lds = (LAS unsigned char*)lds_raw; F.ws = args.ws; F.ctl = (gu32*)(args.ws + WS_CTL);
    F.tid = threadIdx.x; F.lane = F.tid & 63; F.wave = __builtin_amdgcn_readfirstlane(F.tid >> 6);
    F.G = gridDim.x; { const int bx = blockIdx.x; F.vcu = (F.G % 8 == 0) ? (bx % 8) * (F.G / 8) + bx / 8 : bx; }
    F.in = args.in; F.out = args.out;
    volatile LAS unsigned* MISC = (volatile LAS unsigned*)(F.lds + MISC_OFF);
    for (int u = F.tid; u < (LDS_BYTES - LDSCTL_OFF) / 4; u += 512) ((LAS unsigned*)(F.lds + LDSCTL_OFF))[u] = 0u;
    __syncthreads();
    XcdBarrier bar; bar.bar = (unsigned*)(F.ctl + CW_BAR); bar.x = 0; bar.st = nullptr;
    if (MK_ONE_LAUNCH) bar = xcd_barrier_post((unsigned*)(F.ctl + CW_BAR), MISC + 8);
    const int lo = args.ph_lo, hi = args.ph_hi;
#ifndef MK_PHASES
#define MK_PHASES 0xFFFFFFFFu
#endif
#define PHEN(j) (((MK_PHASES) >> (j)) & 1u)
#define IN(k) (lo <= (k) && (k) < hi)
#ifndef MK_DUP
#define MK_DUP 0u
#endif
#ifndef MK_DUPN
#define MK_DUPN 2
#endif
#define REPS(j) ((((MK_DUP) >> (j)) & 1u) ? MK_DUPN : 1)
#define REPLOOP(j) for (int rep = 0; rep < REPS(j); ++rep)
#define REPBAR() do { if (rep) xcd_barrier(bar); } while (0)
    const float* const gate_zero = (const float*)(F.ctl + 65536);
#define SEAM_BODY() do { if (MK_CONV_SEAM && cv_target < DEPTH) { const XbTok tk_ = xcd_arrive(bar); \
        volatile LAS int* bc_ = (volatile LAS int*)(F.lds + LDSCTL_OFF + 512); \
        if (lt_tid() == 0) bc_[0] = (tk_.role == 0) ? (int)__hip_atomic_fetch_add(F.ctl + CW_Q + 64 * (cv_target * 8 + (int)(bar.x & 7u)), 1u, RLX_AGENT) : 0x7fffff;     \
        __syncthreads(); \
        { const int t_ = (bc_[0] * 8 + (int)(bar.x & 7u)) * 8 + F.wave; if (t_ < conv_ntiles(cv_target)) conv_tile(F, cv_target, t_, (LAS float*)(F.lds + F.wave * 16640), lt_tid() & 63); } \
        xcd_wait(bar, tk_); } else xcd_barrier(bar); } while (0)
#define SEAM(k) do { if (IN(k) && IN((k) + 1)) SEAM_BODY(); } while (0)
    int cv_target = DEPTH, cv_next = 0, cv_prev_done = 0;
    bf16* const HB = (bf16*)(F.ws + WS_HB); float* const X = (float*)(F.ws + WS_X);
    const float* const mod = (const float*)(F.ws + WS_MOD);

#ifdef MK_XBAR
    if (MK_ONE_LAUNCH) for (int xb = 0; xb < MK_XBAR; ++xb) xcd_barrier(bar);
#endif
    if (IN(0) && PHEN(20)) REPLOOP(20) { REPBAR(); mod_phase(F); }
    SEAM(0);
    for (int l = 0; l < DEPTH; ++l) {
        const int pb = 1 + l * NPL;
        const bool last = (l == DEPTH - 1), moe = (l & 1) != 0;
        cv_target = (MK_ONE_LAUNCH && l + 1 < DEPTH && ((l + 1) & 1)) ? l + 1 : DEPTH; cv_next = 0;
        if (IN(pb + 0) && PHEN(0)) {
            for (int rep = 0; rep < REPS(14); ++rep) { for (int it = F.vcu; it < NG * 8; it += F.G) ssm_prepA(F, l, it >> 3, it & 7); }
            __syncthreads();
            if (MK_CONV_SEAM && MK_ONE_LAUNCH && (l & 1)) wconv_drain(F, l, bar.x); else
            for (int rep = 0; rep < REPS(15); ++rep) wconv_phase(F, l, 0);
            for (int rep = 0; rep < REPS(16); ++rep) norm_phase<0>(F, l, MTOT, l == 0 && rep == 0, l > 0 && ((l - 1) & 1) && rep == 0, false, ((l & 1) && rep == 0 && MK_SPLIT_FFN2 > 1) ? mod + ((size_t)(l - 1) * 9 + 8) * 6144 + 5 * 1024 : nullptr, MK_SPLIT_FFN2);
        }
        SEAM(pb + 0);
        if (IN(pb + 1) && PHEN(1)) REPLOOP(1) { REPBAR();
            pg8::Gemm g{HB, (const bf16*)(F.ws + ws_win(l)), 1024, 1024, 1024};
            pg8::TileOrder S; S.init(MTOT / 256, INW / 256, F.G, (int)blockIdx.x, (size_t)256 * 1024 * 2, (size_t)256 * 1024 * 2, 0); S.wgm = MK_WGM_INP;
            EpiInProj E{(bf16*)(F.ws + WS_AY), (bf16*)(F.ws + WS_Q), (bf16*)(F.ws + WS_K), (bf16*)(F.ws + WS_V)};
            pg8::gemm_phase(F.lds, g, S, E);
            if (MK_SSM_FUSED && rep == 0 && !MK_DIAG_PREPB) { for (int it = F.vcu; it < NG * 8; it += F.G) ssm_prepB(F, l, it >> 3, it & 7); }
        }
        SEAM(pb + 1);
#if MK_SSM_FUSED
        if (IN(pb + 2) && (PHEN(2) || PHEN(5))) {
            if (MK_DIAG_PREPB) { for (int it = F.vcu; it < NG * 8; it += F.G) ssm_prepB(F, l, it >> 3, it & 7); xcd_barrier(bar); }
            if (PHEN(5)) for (int rep = 0; rep < REPS(5); ++rep) { if (rep) xcd_barrier(bar); __syncthreads(); attn_phase(F, l, !last, F.vcu, (2048 - F.vcu + F.G - 1) / F.G, F.G); }
            if (PHEN(2)) for (int rep = 0; rep < REPS(2); ++rep) { if (rep) xcd_barrier(bar); for (int it = F.vcu; it < 256; it += F.G) ssm_item(F, l, it >> 5, it & 31, last); }
        }
        SEAM(pb + 2);
#else
        if (IN(pb + 2) && PHEN(2)) REPLOOP(2) { REPBAR();
            pg8::Gemm g{(const bf16*)(F.ws + WS_AY), (const bf16*)(F.ws + WS_BTS), 512, KY, 512};
            pg8::TileOrder S; S.init(NG * 5, 1, F.G, (int)blockIdx.x, (size_t)256 * KY * 2, (size_t)256 * 512 * 2, 5); S.wgm = MK_WGM_SSM;
            EpiS E{(float*)(F.ws + WS_S)};
            pg8::gemm_phase(F.lds, g, S, E);
            if (MK_ATT_SPREAD && rep == 0 && (int)blockIdx.x >= 160) { __syncthreads(); attn_phase(F, l, false, (int)blockIdx.x - 160, 1, 1); }
        }
        SEAM(pb + 2);
        if (IN(pb + 3) && PHEN(3)) REPLOOP(3) { REPBAR(); carry_phase(F, l); for (int it = F.vcu; it < NG * 8; it += F.G) ssm_prepB(F, l, it >> 3, it & 7); }
        if (IN(pb + 3) && PHEN(5)) REPLOOP(5) { if (rep) xcd_barrier(bar); __syncthreads();
            const int a0 = MK_ATT_SPREAD ? 480 + F.vcu : F.vcu; attn_phase(F, l, !last, a0, (2048 - a0 + F.G - 1) / F.G, F.G); }
        SEAM(pb + 3);
        if (IN(pb + 4) && PHEN(4)) REPLOOP(4) { REPBAR();
            pg8::Gemm g{(const bf16*)(F.ws + WS_AY), (const bf16*)(F.ws + WS_BTY), KY, KY, KY};
            pg8::TileOrder S; S.init(NG * 5, 2, F.G, (int)blockIdx.x, (size_t)256 * KY * 2, (size_t)256 * KY * 2, 5);
            if (last) { S.init(NG * 4, 2, F.G, (int)blockIdx.x, (size_t)256 * KY * 2, (size_t)256 * KY * 2, 5); S.skip5 = 1; }
            S.wgm = MK_WGM_SSM;
            EpiY E{(bf16*)(F.ws + WS_G)};
            pg8::gemm_phase(F.lds, g, S, E);
            if (MK_ATT_SPREAD && rep == 0 && (int)blockIdx.x >= 64) { __syncthreads(); attn_phase(F, l, false, 96 + ((int)blockIdx.x - 64) * 2, 2, 1); }
        }
        SEAM(pb + 4);
#endif
        if (IN(pb + 6) && PHEN(6)) REPLOOP(6) { REPBAR();
            pg8::Gemm g{(const bf16*)(F.ws + WS_G), (const bf16*)(F.ws + ws_wglu(l)), 512, 512, 512};
            pg8::TileOrder S; S.init((last ? MLAT : MTOT) / 256, 2, F.G, (int)blockIdx.x, (size_t)256 * 512 * 2, (size_t)256 * 512 * 2, 0);
            S.wgm = MK_WGM_GLU;
            EpiGlu E{(const bf16*)(F.ws + WS_G), F.in[I_GLUB] + l * 512, (bf16*)(F.ws + WS_YA)};
            pg8::gemm_phase(F.lds, g, S, E);
        }
        SEAM(pb + 6);
        if (IN(pb + 7) && PHEN(7)) REPLOOP(7) { REPBAR();
            pg8::Gemm g{(const bf16*)(F.ws + WS_YA), (const bf16*)(F.ws + ws_wout(l)), 1024, 1024, 1024};
            pg8::TileOrder S; S.init((last ? MLAT : MTOT) / 256, 4, F.G, (int)blockIdx.x, (size_t)256 * 1024 * 2, (size_t)256 * 1024 * 2, 0); if (!last && MK_SPLIT_OUT > 1) { S.init(MLAT / 256, 4, F.G, (int)blockIdx.x, (size_t)256 * 1024 * 2, (size_t)256 * 1024 * 2, 0); S.ntk = 16; S.nsplit = MK_SPLIT_OUT; S.xpm0 = MLAT / 256; S.xnp = MCTX / 256; }
            S.wgm = MK_WGM_OUT;
#ifdef MK_NULLEPI3
            if (rep) { EpiNull E{(float*)(F.ws + WS_G)}; pg8::gemm_phase(F.lds, g, S, E); } else
#endif
            { EpiRes E{X, rep ? gate_zero : mod + (size_t)l * 9 * 6144 + 2 * 1024, (float*)(F.ws + WS_SLAB)};
            pg8::gemm_phase(F.lds, g, S, E); }
        }
        SEAM(pb + 7);
        const int MF = last ? MLAT : MTOT;
        if (IN(pb + 8) && PHEN(8)) REPLOOP(8) { REPBAR(); norm_phase<1>(F, l, MF, false, false, moe && rep == 0, (!last && rep == 0 && MK_SPLIT_OUT > 1) ? mod + ((size_t)l * 9 + 8) * 6144 + 2 * 1024 : nullptr, MK_SPLIT_OUT); }
        SEAM(pb + 8);
        if (!moe) {
            if (IN(pb + 9) && PHEN(9)) REPLOOP(9) { REPBAR();
                pg8::Gemm g{HB, (const bf16*)(F.ws + WS_DW13), 1024, 1024, 1024};
                pg8::TileOrder S; S.init(MF / 256, 22, F.G, (int)blockIdx.x, (size_t)256 * 1024 * 2, (size_t)256 * 1024 * 2, 0);
                EpiSwiGlu E{(bf16*)(F.ws + WS_ACT), ACT_LD, 0, MK_BLOCKED_ACT};
                pg8::gemm_phase(F.lds, g, S, E);
            }
            SEAM(pb + 9);
            if (IN(pb + 10) && PHEN(10)) REPLOOP(10) { REPBAR();
                pg8::Gemm g{(const bf16*)(F.ws + WS_ACT), (const bf16*)(F.ws + WS_DW2), DFF, MK_BLOCKED_ACT ? 64 : ACT_LD, DW2_LD, MK_BLOCKED_ACT ? 256 * 128 : 128};
                pg8::TileOrder S; S.init(MF / 256, 4, F.G, (int)blockIdx.x, (size_t)256 * ACT_LD * 2, (size_t)256 * DW2_LD * 2, 0); if (!last && MK_SPLIT_FFN2 > 1) { S.init(MLAT / 256, 4, F.G, (int)blockIdx.x, (size_t)256 * ACT_LD * 2, (size_t)256 * DW2_LD * 2, 0); S.ntk = 44; S.nsplit = MK_SPLIT_FFN2; S.xpm0 = MLAT / 256; S.xnp = MCTX / 256; }
                if (MK_BLOCKED_ACT) S.kpA = 2 * 256 * 128;
                S.wgm = MK_WGM_F2;
#ifdef MK_NULLEPI2
                if (rep) { EpiNull E{(float*)(F.ws + WS_YA)}; pg8::gemm_phase(F.lds, g, S, E); } else
#endif
                { EpiRes E{X, rep ? gate_zero : mod + (size_t)l * 9 * 6144 + 5 * 1024, (float*)(F.ws + WS_SLAB)};
                pg8::gemm_phase(F.lds, g, S, E); }
            }
            if (IN(pb + 10) && IN(pb + NPL)) SEAM_BODY();
        } else {
            if (IN(pb + 9) && PHEN(11)) { scatter_phase(F, l, MF, 1); }
            SEAM(pb + 9);
            const unsigned* cnt = (const unsigned*)F.ctl + CW_CNT + (l >> 1) * 16;
            {
                int segp[9]; moe_seg(cnt, segp);
                const int P = segp[8];
                if (IN(pb + 10) && PHEN(12)) REPLOOP(12) { REPBAR();
                    pg8::Gemm g{(const bf16*)(F.ws + WS_XS), (const bf16*)(F.ws + WS_W13), 1024, 1024, 1024};
                    pg8::MoeOrder S; S.nM = P; S.nN = 28; S.nwg = P * 28; S.G = F.G; S.c = (int)blockIdx.x; S.p0 = 0; S.sA = (size_t)256 * 1024 * 2; S.sB = (size_t)256 * 1024 * 2; S.a_local = 0; S.wgm = MK_WGM_M1;
#pragma unroll
                    for (int j = 0; j < 9; ++j) S.segp[j] = segp[j];
                    EpiSwiGlu E{(bf16*)(F.ws + WS_ACTS), DFE, 0, 0};
                    pg8::gemm_phase(F.lds, g, S, E);
                }
                SEAM(pb + 10);
                if (IN(pb + 11) && PHEN(13)) REPLOOP(13) { REPBAR();
                    pg8::Gemm g{(const bf16*)(F.ws + WS_ACTS), (const bf16*)(F.ws + WS_W2), DFE, DFE, DFE};
                    const int Pm = (P >> 6) << 6, xl = P - Pm;
                    const bool spl = MK_SPLIT_M2 && xl > 0 && xl <= 32 && F.G == 256;
                    pg8::MoeOrder S; S.nM = spl ? Pm : P; S.nN = 4; S.nwg = S.nM * 4; S.G = F.G; S.c = (int)blockIdx.x; S.p0 = 0; S.sA = (size_t)256 * DFE * 2; S.sB = (size_t)256 * DFE * 2; S.a_local = 0;
                    if (spl) { S.xpm0 = Pm; S.xnp = xl; S.ntk = 56; }
                    S.wgm = MK_WGM_M2;
#pragma unroll
                    for (int j = 0; j < 9; ++j) S.segp[j] = segp[j];
                    EpiPlain E{(bf16*)(F.ws + WS_YS), 1024, (bf16*)(F.ws + WS_SLAB), Pm};
                    pg8::gemm_phase(F.lds, g, S, E);
                }
                if (IN(pb + 11) && IN(pb + NPL)) SEAM_BODY();
            }
        }
        cv_prev_done = (cv_target < DEPTH) ? (cv_next < conv_ntiles(cv_target) ? cv_next : conv_ntiles(cv_target)) : 0;
    }
    if (IN(NPHASE - 1) && PHEN(21)) { norm_phase<2>(F, DEPTH, MLAT, false, true, false, nullptr, 1); }
#undef IN
#undef SEAM
}

extern "C" void kernel_launch(void* const* d_in, const int* in_sizes, int n_in, void* d_out, int out_size, void* d_ws, size_t ws_size, hipStream_t stream) {
    static int grid = 0;
    if (grid == 0) {
        if (n_in != 29 || out_size != MLAT * D || ws_size < WS_END) { fprintf(stderr, "kernel_launch: unexpected shapes (n_in %d out %d ws %zu)\n", n_in, out_size, ws_size); grid = -1; return; }
        int dev = 0, cus = 0, per_cu = 0;
        if (hipGetDevice(&dev) != hipSuccess || hipDeviceGetAttribute(&cus, hipDeviceAttributeMultiprocessorCount, dev) != hipSuccess) { grid = -1; return; }
        if (hipFuncSetAttribute((const void*)mk_fwd, hipFuncAttributeMaxDynamicSharedMemorySize, LDS_BYTES) != hipSuccess) { fprintf(stderr, "kernel_launch: hipFuncSetAttribute failed\n"); grid = -1; return; }
        if (hipOccupancyMaxActiveBlocksPerMultiprocessor(&per_cu, (const void*)mk_fwd, 512, LDS_BYTES) != hipSuccess || per_cu < 1) fprintf(stderr, "kernel_launch: occupancy query says %d\n", per_cu);
        (void)hipGetLastError();
        grid = cus;
        if (grid != 256) { fprintf(stderr, "kernel_launch: %d CUs, expected 256\n", cus); grid = 256; }
    }
    if (grid < 0) return;
    (void)hipMemsetAsync((char*)d_ws + WS_CTL, 0, CTL_ZERO_BYTES, stream);
    Args a{};
    for (int i = 0; i < 29; ++i) a.in[i] = (const float*)d_in[i];
    a.out = (float*)d_out; a.ws = (unsigned char*)d_ws;
#if MK_ONE_LAUNCH
    a.ph_lo = 0; a.ph_hi = NPHASE;
    hipLaunchKernelGGL(mk_fwd, dim3(grid), dim3(512), LDS_BYTES, stream, a);
#else
    for (int ph = 0; ph < NPHASE; ++ph) {
        if (ph >= 1 && ph < NPHASE - 1) { const int l = (ph - 1) / NPL, j = (ph - 1) % NPL; if (!(l & 1) && j >= 11) continue; }
        a.ph_lo = ph; a.ph_hi = ph + 1;
        hipLaunchKernelGGL(mk_fwd, dim3(grid), dim3(512), LDS_BYTES, stream, a);
    }
#endif
}
```

```cpp
#include <hip/hip_runtime.h>
#include <cstdio>
#include <cstdint>

#define MK_DIAG_PREPB 0
#define MK_DW2_LD 2816
#define MK_BLOCKED_ACT 0
#define MK_SSM_FUSED 1
#define MK_ACT_LD 2816
#define MK_WGM 4
#define MK_WGM_M1 4
#define MK_WGM_SSM 8
#define MK_WGM_INP 4
#define MK_WGM_GLU 4
#define MK_WGM_OUT 4
#define MK_WGM_F1 4
#define MK_WGM_F2 4
#define MK_WGM_M2 2
#define MK_SPLIT_M2 1
#define MK_CONV_SEAM 1
#define MK_ALIGN_EPI 1
#define MK_ATT_SPREAD 1
#define MK_WT_STORES 0
#define MK_SPLIT_OUT 4
#define MK_SPLIT_FFN2 4
#ifndef MK_ONE_LAUNCH
#define MK_ONE_LAUNCH 1
#endif

#define GAS __attribute__((address_space(1)))
#define LAS __attribute__((address_space(3)))
typedef unsigned short bf16;
typedef unsigned v4u __attribute__((ext_vector_type(4)));
typedef unsigned v2u __attribute__((ext_vector_type(2)));
typedef float f32x4 __attribute__((ext_vector_type(4)));
typedef float f32x2 __attribute__((ext_vector_type(2)));
typedef short bf16x8 __attribute__((ext_vector_type(8)));
typedef short bf16x4 __attribute__((ext_vector_type(4)));
typedef GAS unsigned gu32;

constexpr int D = 1024, NBATCH = 8, SEQ = 4096, DEPTH = 4, CTXL = 256;
constexpr int MLAT = NBATCH * SEQ, MCTX = NBATCH * CTXL, MTOT = MLAT + MCTX;
constexpr int SSMW = 512, NG = 32, NPS = 64, ATTW = 512, HD = 64, NH = 8, INW = 2048, DFF = 2816, NE = 8, DFE = 3584;
constexpr int NCRP = 1280, KY = 768;
constexpr float NORM_EPS = 1e-6f;
constexpr float QSCALE = 0.125f * 1.4426950408889634f;
constexpr float LOG2E = 1.4426950408889634f;
constexpr int MOE_MAXP = 280, MOE_HALFP = 140;
constexpr int DW2_LD = MK_DW2_LD;
constexpr int ACT_LD = MK_ACT_LD;

constexpr size_t MiB = 1u << 20;
constexpr size_t WS_CTL = 0, CTL_ZERO_BYTES = 1 * MiB;
constexpr size_t WS_MOD = 1 * MiB;
constexpr size_t WS_ROUTE = 2 * MiB;
constexpr size_t WS_BTS = 4 * MiB;
constexpr size_t WS_BTY = 12 * MiB;
constexpr size_t WS_WIN = 36 * MiB;
constexpr size_t WS_WOUT = 40 * MiB;
constexpr size_t WS_WGLU = 42 * MiB;
constexpr size_t WS_W13 = 44 * MiB;
constexpr size_t WS_W2 = 156 * MiB;
constexpr size_t WS_DW13 = 720 * MiB, WS_DW2 = 731 * MiB;
constexpr size_t WS_WIN1 = 740 * MiB, WS_WOUT1 = 744 * MiB, WS_WGLU1 = 746 * MiB;
__device__ __forceinline__ size_t ws_win(int l) { return (l & 1) ? WS_WIN1 : (size_t)(36 * MiB); }
__device__ __forceinline__ size_t ws_wout(int l) { return (l & 1) ? WS_WOUT1 : (size_t)(40 * MiB); }
__device__ __forceinline__ size_t ws_wglu(int l) { return (l & 1) ? WS_WGLU1 : (size_t)(42 * MiB); }
__device__ __forceinline__ size_t ws_w13(int l) { return (l & 1) ? WS_W13 : WS_DW13; }
__device__ __forceinline__ size_t ws_w2(int l) { return (l & 1) ? WS_W2 : WS_DW2; }
constexpr size_t WS_X = 212 * MiB;
constexpr size_t WS_HB = 348 * MiB;
constexpr size_t WS_AY = 416 * MiB;
constexpr size_t WS_S = 476 * MiB;
constexpr size_t WS_Q = 516 * MiB, WS_K = 550 * MiB, WS_V = 584 * MiB;
static_assert(WS_V - WS_K == WS_K - WS_Q, "q/k/v spacing");
constexpr size_t WS_G = 618 * MiB;
constexpr size_t WS_YA = 652 * MiB;
constexpr size_t WS_ACT = 416 * MiB;
constexpr size_t WS_XS = 838 * MiB;
constexpr size_t WS_ACTS = 348 * MiB;
constexpr size_t WS_YS = WS_XS;
constexpr size_t WS_KTG = 978 * MiB;
constexpr size_t WS_SLAB = 980 * MiB;
constexpr size_t WS_END = 1012 * MiB;
constexpr int CW_TMO = 0;
constexpr int CW_BAR = 4096;
constexpr int CW_CNT = 8192;
constexpr int CW_CUR = 8256;
constexpr int CW_BCNT = 24576;
constexpr int CW_Q = 12288;

constexpr int RING_BYTES = 131072;
constexpr int LDSCTL_OFF = 144 * 1024, MISC_OFF = LDSCTL_OFF + 320;
constexpr int LDS_BYTES = 152 * 1024;

#define RLX_AGENT __ATOMIC_RELAXED, __HIP_MEMORY_SCOPE_AGENT
#define LDS_WAIT() asm volatile("s_waitcnt lgkmcnt(0)" ::: "memory")
#define VM_WAIT() asm volatile("s_waitcnt vmcnt(0)" ::: "memory")
__device__ __forceinline__ unsigned f2bf(float f) { unsigned u = __builtin_bit_cast(unsigned, f); return (u + 0x7fffu + ((u >> 16) & 1u)) >> 16; }
__device__ __forceinline__ unsigned pk2(float lo, float hi) { return f2bf(lo) | (f2bf(hi) << 16); }
__device__ __forceinline__ float bf2f(unsigned short b) { return __builtin_bit_cast(float, ((unsigned)b) << 16); }
__device__ __forceinline__ float bflo(unsigned w) { return __builtin_bit_cast(float, w << 16); }
__device__ __forceinline__ float bfhi(unsigned w) { return __builtin_bit_cast(float, w & 0xffff0000u); }
typedef __bf16 bf16x2_t __attribute__((ext_vector_type(2)));
__device__ __forceinline__ unsigned cvt_pk_bf16(float lo, float hi) { const f32x2 v = {lo, hi}; const bf16x2_t b = __builtin_convertvector(v, bf16x2_t); return __builtin_bit_cast(unsigned, b); }
__device__ __forceinline__ float fast_rcp(float x) { return __builtin_amdgcn_rcpf(x); }
__device__ __forceinline__ float sigmoidf_(float x) { return fast_rcp(1.0f + __builtin_amdgcn_exp2f(-x * LOG2E)); }
__device__ __forceinline__ float siluf_(float x) { return x * sigmoidf_(x); }
__device__ __forceinline__ float gelu_tanh(float x) {
    const float u = 0.7978845608028654f * (x + 0.044715f * x * x * x);
    return x * sigmoidf_(2.0f * u);
}
__device__ __forceinline__ float wave_sum(float v) {
#pragma unroll
    for (int o = 1; o < 64; o <<= 1) v += __shfl_xor(v, o);
    return v;
}

__device__ __forceinline__ int lt_s(int v) { asm volatile("" : "+s"(v)); return v; }
__device__ __forceinline__ int lt_tid() { int t = threadIdx.x; asm volatile("" : "+v"(t)); return t; }

namespace pg8 {
#define PG8_LAS __attribute__((address_space(3)))
typedef unsigned short bf16_t;
constexpr int BM = 256, BK = 64, HALF = 128, HTB = HALF * BK * 2, STAGE_BYTES = 8 * HTB, NXCD = 8, WGM = MK_WGM;
__host__ __device__ __forceinline__ int lds_byte(int r, int c) { const int st = (r >> 4) * 2 + (c >> 5), rr = r & 15, cc = c & 31, ob = rr * 64 + cc * 2; return st * 1024 + (ob ^ (((ob >> 9) & 1) << 5)); }
__host__ __device__ __forceinline__ void stage_rc(int b, int& R, int& C) { const int st = b / 1024, sb = b % 1024, swz = sb ^ (((sb >> 9) & 1) << 5); R = (st >> 1) * 16 + swz / 64; C = (st & 1) * 32 + (swz % 64) / 2; }
__host__ __device__ __forceinline__ int perm32(int rho) { const int n = rho >> 4, i = rho & 15; return 8 * (i >> 2) + 4 * n + (i & 3); }

struct Unit { int pm, pn; size_t aoff, boff; int nt, atomic; };
struct Gemm { const bf16_t* A; const bf16_t* Bt; int K, lda, ldb; int kstepA = BK * 2; };

struct TileOrder {
    int nM, nN, nwg, G, c; size_t sA, sB; int bdiv;
    int wgm = WGM; int skip5 = 0; int kpA = 256;
    int ntk = 0, nsplit = 1, xpm0 = 0, xnp = 0;
    __device__ void init(int nM_, int nN_, int G_, int c_, size_t sA_, size_t sB_, int bdiv_) { nM = nM_; nN = nN_; nwg = nM * nN; G = G_; c = c_; sA = sA_; sB = sB_; bdiv = bdiv_; }
    __device__ bool next(int i, Unit& u) const {
        const long L = (long)i * G + c;
        u.nt = 0; u.atomic = 0;
        if (L >= nwg) {
            if (xnp == 0) return false;
            const int Lp = (int)(L - nwg); if (Lp >= xnp * nN * nsplit) return false;
            const int uu = Lp / nsplit, part = Lp - uu * nsplit;
            u.pm = xpm0 + uu / nN; u.pn = uu % nN; u.atomic = 1 + part;
            const int pairs = ntk / 2, base = pairs / nsplit, rem = pairs % nsplit; const int np = base + (part < rem ? 1 : 0), p0 = part * base + (part < rem ? part : rem);
            u.nt = 2 * np; u.aoff = (size_t)u.pm * sA + (size_t)p0 * kpA; u.boff = (size_t)u.pn * sB + (size_t)p0 * 256;
            return true;
        }
        int wgid = (int)L; { const int q = nwg / NXCD, r = nwg % NXCD, xcd = wgid % NXCD, off = wgid / NXCD; wgid = (xcd < r ? xcd * (q + 1) : r * (q + 1) + (xcd - r) * q) + off; }
        const int nig = wgm * nN, gid = wgid / nig, fm = gid * wgm, gsz = (nM - fm) < wgm ? (nM - fm) : wgm;
        u.pm = fm + ((wgid % nig) % gsz); u.pn = (wgid % nig) / gsz;
        if (skip5) u.pm = (u.pm >> 2) * 5 + (u.pm & 3);
        u.aoff = (size_t)u.pm * sA; u.boff = (size_t)(bdiv > 0 ? (u.pm / bdiv) * nN + u.pn : u.pn) * sB;
        return true;
    }
};
struct MoeOrder {
    int nM, nN, nwg, G, c, p0; size_t sA, sB; int segp[9]; int a_local;
    int wgm = WGM;
    int xpm0 = 0, xnp = 0, ntk = 0;
    __device__ bool next(int i, Unit& u) const {
        const long L = (long)i * G + c;
        int pl;
        if (L >= nwg) {
            if (xnp == 0) return false;
            const int Lp = (int)(L - nwg); if (Lp >= xnp * nN * 2) return false;
            const int uu = Lp >> 1, part = Lp & 1;
            pl = xpm0 + uu / nN; u.pn = uu % nN; u.pm = p0 + pl; u.nt = ntk / 2; u.atomic = 1 + part;
            int e = 0;
#pragma unroll
            for (int j = 1; j < 8; ++j) e += (u.pm >= segp[j]) ? 1 : 0;
            const size_t ko = (size_t)part * (size_t)(ntk / 2) * 128;
            u.aoff = (size_t)(a_local ? pl : u.pm) * sA + ko; u.boff = (size_t)(e * nN + u.pn) * sB + ko; return true;
        }
        int wgid = (int)L; { const int q = nwg / NXCD, r = nwg % NXCD, xcd = wgid % NXCD, off = wgid / NXCD; wgid = (xcd < r ? xcd * (q + 1) : r * (q + 1) + (xcd - r) * q) + off; }
        const int nig = wgm * nN, gid = wgid / nig, fm = gid * wgm, gsz = (nM - fm) < wgm ? (nM - fm) : wgm;
        pl = fm + ((wgid % nig) % gsz); u.pn = (wgid % nig) / gsz; u.pm = p0 + pl;
        int e = 0;
#pragma unroll
        for (int j = 1; j < 8; ++j) e += (u.pm >= segp[j]) ? 1 : 0;
        u.aoff = (size_t)(a_local ? pl : u.pm) * sA; u.boff = (size_t)(e * nN + u.pn) * sB; u.nt = 0; u.atomic = 0; return true;
    }
};

constexpr int GIDX_OFF = 8 * HTB; constexpr unsigned GATHER_MAXROW = 34815u;
template <class Epi, class Sched, bool GATHER = false>
__device__ __forceinline__ void gemm_phase(PG8_LAS unsigned char* lds, const Gemm g, const Sched& S, const Epi& E, const int* gidx = nullptr) {
    const int tid = lt_tid(), wid = __builtin_amdgcn_readfirstlane(tid >> 6), lane = tid & 63, wr = wid >> 2, wc = wid & 3, fr = lane & 15, fq = lane >> 4;
    const int K = g.K, nt = K / BK;
    unsigned voffA[2], voffB[2], voffA1[2], rcA[2];
#pragma unroll
    for (int i = 0; i < 2; ++i) { int R, C; stage_rc(tid * 16 + i * 8192, R, C); const int Rb = Epi::PERM ? ((R & ~31) + perm32(R & 31)) : R;
        voffA[i] = (unsigned)(R * g.lda + C) * 2u; voffB[i] = (unsigned)(Rb * g.ldb + C) * 2u; voffA1[i] = 0u; rcA[i] = (unsigned)(R * 4) | ((unsigned)(C * 2) << 16); }
    const size_t kstep = (size_t)(BK * 2), kstepA = (size_t)g.kstepA;
    const size_t hstepA = GATHER ? (size_t)0 : (size_t)HALF * g.lda * 2, hstepB = (size_t)HALF * g.ldb * 2;
    const unsigned rowbA = (unsigned)g.lda * 2u;
    const unsigned ldsw = (unsigned)wid * 1024u;
    const int aoff = lds_byte(wr * 64 + fr, fq * 8), boff = lds_byte(wc * 32 + fr, fq * 8);
#define PG8_SA(b, h) (((b) * 2 + (h)) * HTB)
#define PG8_SB(b, h) ((4 + (b) * 2 + (h)) * HTB)
#define PG8_STAGE(bufoff, gbase, voff) do { _Pragma("unroll") for (int _i = 0; _i < 2; ++_i) \
        __builtin_amdgcn_global_load_lds((const unsigned*)((const char*)(gbase) + (voff)[_i]), (PG8_LAS unsigned*)(lds + (bufoff) + ldsw + _i * 8192), 16, 0, 0); } while (0)
#define PG8_STAGE_H1(bufoff, gbase) do { if (GATHER) PG8_STAGE(bufoff, gbase, voffA1); else PG8_STAGE(bufoff, (gbase) + hstepA, voffA); } while (0)
#define PG8_LDA(dst, b, h) do { _Pragma("unroll") for (int m = 0; m < 4; ++m) _Pragma("unroll") for (int k = 0; k < 2; ++k) dst[m][k] = *(const PG8_LAS bf16x8*)(lds + PG8_SA(b, h) + aoff + m * 2048 + k * 1024); } while (0)
#define PG8_LDB(dst, b, h) do { _Pragma("unroll") for (int n = 0; n < 2; ++n) _Pragma("unroll") for (int k = 0; k < 2; ++k) dst[n][k] = *(const PG8_LAS bf16x8*)(lds + PG8_SB(b, h) + boff + n * 2048 + k * 1024); } while (0)
#define PG8_MMA(ai, bj, At, Bt) do { __builtin_amdgcn_s_setprio(1); _Pragma("unroll") for (int m = 0; m < 4; ++m) _Pragma("unroll") for (int n = 0; n < 2; ++n) _Pragma("unroll") for (int k = 0; k < 2; ++k) \
        acc[ai][bj][m][n] = __builtin_amdgcn_mfma_f32_16x16x32_bf16(Bt[n][k], At[m][k], acc[ai][bj][m][n], 0, 0, 0); __builtin_amdgcn_s_setprio(0); } while (0)
#define PG8_WAIT_V(n) asm volatile("s_waitcnt vmcnt(" #n ")" ::: "memory")
#define PG8_WAIT_L(n) asm volatile("s_waitcnt lgkmcnt(" #n ")" ::: "memory")
#define PG8_BAR __builtin_amdgcn_s_barrier()
#define PG8_SCHED __builtin_amdgcn_sched_barrier(0)
    Unit cur, nxt; int ui = 0;
    if (!S.next(0, cur)) return;
    f32x4 acc[2][2][4][2];
#pragma unroll
    for (int a = 0; a < 2; ++a)
#pragma unroll
        for (int b = 0; b < 2; ++b)
#pragma unroll
            for (int m = 0; m < 4; ++m)
#pragma unroll
                for (int n = 0; n < 2; ++n) acc[a][b][m][n] = (f32x4){0.f, 0.f, 0.f, 0.f};
    bf16x8 At[4][2], B0[2][2], B1[2][2];
    const char* cA = (const char*)g.A + (GATHER ? (size_t)0 : cur.aoff); const char* cB = (const char*)g.Bt + cur.boff;
    if (GATHER) {
#pragma unroll
        for (int i = 0; i < 2; ++i) { const int r_ = (int)(rcA[i] & 0xFFFFu) >> 2; const unsigned c2_ = rcA[i] >> 16;
            const unsigned i0 = (unsigned)gidx[cur.pm * 256 + r_], i1 = (unsigned)gidx[cur.pm * 256 + 128 + r_];
            voffA[i] = (i0 < GATHER_MAXROW ? i0 : GATHER_MAXROW) * rowbA + c2_; voffA1[i] = (i1 < GATHER_MAXROW ? i1 : GATHER_MAXROW) * rowbA + c2_; }
    }
    PG8_STAGE(PG8_SB(0, 0), cB, voffB); PG8_STAGE(PG8_SB(0, 1), cB + hstepB, voffB); PG8_STAGE(PG8_SA(0, 0), cA, voffA); PG8_STAGE_H1(PG8_SA(0, 1), cA);
    if (wr == 1) PG8_BAR;
    PG8_WAIT_V(2); PG8_BAR;
    PG8_STAGE(PG8_SB(1, 0), cB + kstep, voffB); PG8_STAGE(PG8_SA(1, 0), cA + kstepA, voffA); PG8_STAGE(PG8_SB(1, 1), cB + hstepB + kstep, voffB);
    PG8_WAIT_V(6); PG8_BAR;
    for (;;) {
        const bool has_next = S.next(ui + 1, nxt);
        const char* nA = has_next ? (const char*)g.A + (GATHER ? (size_t)0 : nxt.aoff) : cA; const char* nB = has_next ? (const char*)g.Bt + nxt.boff : cB;
        if (GATHER && has_next && wid < 4)
            __builtin_amdgcn_global_load_lds((const unsigned*)(gidx + nxt.pm * 256 + wid * 64 + lane), (PG8_LAS unsigned*)(lds + GIDX_OFF + ((ui + 1) & 1) * 1024 + wid * 256), 4, 0, 0);
        const int ntc = cur.nt ? cur.nt : nt;
        for (int t = 0; t < ntc; t += 2) {
            const bool last = (t == ntc - 2);
            const char* a1 = cA + (size_t)(t + 1) * kstepA;
            const char* a2 = last ? nA : cA + (size_t)(t + 2) * kstepA; const char* b2 = last ? nB : cB + (size_t)(t + 2) * kstep;
            const char* a3 = a2 + kstepA; const char* b3 = b2 + kstep;
            PG8_LDB(B0, 0, 0); PG8_LDB(B1, 0, 1); PG8_SCHED; PG8_LDA(At, 0, 0); PG8_STAGE_H1(PG8_SA(1, 1), a1);
            if (GATHER && last && has_next) {
                const PG8_LAS unsigned char* ib = lds + GIDX_OFF + ((ui + 1) & 1) * 1024;
#pragma unroll
                for (int i = 0; i < 2; ++i) { const unsigned r4_ = rcA[i] & 0xFFFFu, c2_ = rcA[i] >> 16;
                    const unsigned i0 = *(const PG8_LAS unsigned*)(ib + r4_), i1 = *(const PG8_LAS unsigned*)(ib + 512 + r4_);
                    voffA[i] = (i0 < GATHER_MAXROW ? i0 : GATHER_MAXROW) * rowbA + c2_; voffA1[i] = (i1 < GATHER_MAXROW ? i1 : GATHER_MAXROW) * rowbA + c2_; }
            }
            PG8_WAIT_V(8); PG8_WAIT_L(0); PG8_BAR; PG8_MMA(0, 0, At, B0); PG8_MMA(0, 1, At, B1); PG8_BAR; PG8_SCHED;
            PG8_LDA(At, 0, 1); PG8_STAGE(PG8_SB(0, 0), b2, voffB); PG8_STAGE(PG8_SB(0, 1), b2 + hstepB, voffB); PG8_STAGE(PG8_SA(0, 0), a2, voffA);
            PG8_WAIT_V(8); PG8_WAIT_L(0); PG8_BAR; PG8_MMA(1, 0, At, B0); PG8_MMA(1, 1, At, B1); PG8_BAR; PG8_SCHED;
            PG8_LDB(B0, 1, 0); PG8_LDB(B1, 1, 1); PG8_SCHED; PG8_LDA(At, 1, 0); PG8_STAGE_H1(PG8_SA(0, 1), a2);
            PG8_WAIT_V(8); PG8_WAIT_L(0); PG8_BAR; PG8_MMA(0, 0, At, B0); PG8_MMA(0, 1, At, B1); PG8_BAR; PG8_SCHED;
            PG8_LDA(At, 1, 1); PG8_STAGE(PG8_SB(1, 0), b3, voffB); PG8_STAGE(PG8_SB(1, 1), b3 + hstepB, voffB); PG8_STAGE(PG8_SA(1, 0), a3, voffA);
            PG8_WAIT_V(8); PG8_WAIT_L(0); PG8_BAR; PG8_MMA(1, 0, At, B0); PG8_MMA(1, 1, At, B1); PG8_BAR; PG8_SCHED;
        }
        if (MK_ALIGN_EPI) { if (wr == 0) PG8_BAR; }
        E(acc, cur, wr, wc, fr, fq);
        if (!has_next) break;
#pragma unroll
        for (int a = 0; a < 2; ++a)
#pragma unroll
            for (int b = 0; b < 2; ++b)
#pragma unroll
                for (int m = 0; m < 4; ++m)
#pragma unroll
                    for (int n = 0; n < 2; ++n) acc[a][b][m][n] = (f32x4){0.f, 0.f, 0.f, 0.f};
        cur = nxt; cA = nA; cB = nB; ++ui;
        if (MK_ALIGN_EPI) { if (wr == 1) PG8_BAR; }
    }
    PG8_WAIT_V(0);
    if (!MK_ALIGN_EPI) { if (wr == 0) PG8_BAR; }
    PG8_BAR;
#undef PG8_SA
#undef PG8_SB
#undef PG8_STAGE
#undef PG8_LDA
#undef PG8_STAGE_H1
#undef PG8_LDB
#undef PG8_MMA
#undef PG8_WAIT_V
#undef PG8_WAIT_L
#undef PG8_BAR
#undef PG8_SCHED
}
}

typedef const f32x4 (&AccRef)[2][2][4][2];
__device__ __forceinline__ v4u pack8(const f32x4& v0, const f32x4& v1) { v4u w; w.x = cvt_pk_bf16(v0[0], v0[1]); w.y = cvt_pk_bf16(v0[2], v0[3]); w.z = cvt_pk_bf16(v1[0], v1[1]); w.w = cvt_pk_bf16(v1[2], v1[3]); return w; }

__device__ __forceinline__ void st16_wt(void* p, v4u v) {
#if MK_WT_STORES
    asm volatile("global_store_dwordx4 %0, %1, off sc1" :: "v"(p), "v"(v) : "memory");
#else
    *(v4u*)p = v;
#endif
}
struct EpiInProj {
    static constexpr bool PERM = true;
    bf16* AY; bf16* Q; bf16* Kb; bf16* V;
    __device__ __forceinline__ void operator()(AccRef acc, const pg8::Unit& u, int wr, int wc, int fr, int fq) const {
        const int row0 = u.pm * 256 + wr * 64 + fr;
        const int sel = u.pn >> 1;
#pragma unroll
        for (int ai = 0; ai < 2; ++ai)
#pragma unroll
            for (int m = 0; m < 4; ++m) {
                const int row = row0 + ai * 128 + m * 16;
#pragma unroll
                for (int bj = 0; bj < 2; ++bj) {
                    const int j0 = (u.pn & 1) * 256 + bj * 128 + wc * 32 + 8 * fq;
                    f32x4 v0 = acc[ai][bj][m][0], v1 = acc[ai][bj][m][1];
                    if (sel == 0) {
                        const int g = j0 >> 4, hh0 = j0 & 15, cr = row >> 5, s = row & 31;
                        *(v4u*)(AY + ((size_t)(g * NCRP + cr) * KY + s * 16 + hh0)) = pack8(v0, v1);
                    } else {
                        bf16* base = Q + (size_t)(sel - 1) * ((WS_K - WS_Q) / 2);
                        if (sel == 1) { v0 = v0 * QSCALE; v1 = v1 * QSCALE; }
                        *(v4u*)(base + (size_t)row * 512 + j0) = pack8(v0, v1);
                    }
                }
            }
    }
};
struct EpiS {
    static constexpr bool PERM = false;
    float* S;
    __device__ __forceinline__ void operator()(AccRef acc, const pg8::Unit& u, int wr, int wc, int fr, int fq) const {
        const int row0 = u.pm * 256 + wr * 64 + fr, col0 = wc * 32 + 4 * fq;
#pragma unroll
        for (int ai = 0; ai < 2; ++ai)
#pragma unroll
            for (int m = 0; m < 4; ++m) { float* rowp = S + (size_t)(row0 + ai * 128 + m * 16) * 256 + col0;
#pragma unroll
                for (int bj = 0; bj < 2; ++bj)
#pragma unroll
                    for (int n = 0; n < 2; ++n) *(f32x4*)(rowp + bj * 128 + n * 16) = acc[ai][bj][m][n]; }
    }
};
struct EpiY {
    static constexpr bool PERM = true;
    bf16* G;
    __device__ __forceinline__ void operator()(AccRef acc, const pg8::Unit& u, int wr, int wc, int fr, int fq) const {
        const int g = u.pm / 5, crb = (u.pm - g * 5) * 256 + wr * 64 + fr;
#pragma unroll
        for (int ai = 0; ai < 2; ++ai)
#pragma unroll
            for (int m = 0; m < 4; ++m) {
                const int cr = crb + ai * 128 + m * 16;
                if (cr < 1088) {
#pragma unroll
                    for (int bj = 0; bj < 2; ++bj) {
                        const int nl = u.pn * 256 + bj * 128 + wc * 32 + 8 * fq, t = nl >> 4, hh0 = nl & 15;
                        f32x4 v0 = acc[ai][bj][m][0], v1 = acc[ai][bj][m][1];
#pragma unroll
                        for (int j = 0; j < 4; ++j) { v0[j] = gelu_tanh(v0[j]); v1[j] = gelu_tanh(v1[j]); }
                        *(v4u*)(G + (size_t)(cr * 32 + t) * 512 + g * 16 + hh0) = pack8(v0, v1);
                    }
                }
            }
    }
};
struct EpiGlu {
    static constexpr bool PERM = true;
    const bf16* G; const float* bias; bf16* YA;
    __device__ __forceinline__ void operator()(AccRef acc, const pg8::Unit& u, int wr, int wc, int fr, int fq) const {
        const int row0 = u.pm * 256 + wr * 64 + fr, c00 = u.pn * 256 + wc * 32 + 8 * fq;
        f32x4 bb[2][2];
#pragma unroll
        for (int bj = 0; bj < 2; ++bj) { bb[bj][0] = *(const f32x4*)(bias + c00 + bj * 128); bb[bj][1] = *(const f32x4*)(bias + c00 + bj * 128 + 4); }
        v4u gr[2][4][2];
#pragma unroll
        for (int ai = 0; ai < 2; ++ai)
#pragma unroll
            for (int m = 0; m < 4; ++m)
#pragma unroll
                for (int bj = 0; bj < 2; ++bj) gr[ai][m][bj] = *(const v4u*)(G + (size_t)(row0 + ai * 128 + m * 16) * 512 + c00 + bj * 128);
#pragma unroll
        for (int ai = 0; ai < 2; ++ai)
#pragma unroll
            for (int m = 0; m < 4; ++m) {
                const int row = row0 + ai * 128 + m * 16;
#pragma unroll
                for (int bj = 0; bj < 2; ++bj) {
                    const int c0 = c00 + bj * 128;
                    const v4u gv = gr[ai][m][bj];
                    f32x4 v0 = acc[ai][bj][m][0] + bb[bj][0], v1 = acc[ai][bj][m][1] + bb[bj][1];
                    const float gg[8] = {bflo(gv.x), bfhi(gv.x), bflo(gv.y), bfhi(gv.y), bflo(gv.z), bfhi(gv.z), bflo(gv.w), bfhi(gv.w)};
#pragma unroll
                    for (int j = 0; j < 4; ++j) { v0[j] = gg[j] * sigmoidf_(v0[j]); v1[j] = gg[4 + j] * sigmoidf_(v1[j]); }
                    *(v4u*)(YA + (size_t)row * 1024 + c0) = pack8(v0, v1);
                }
            }
    }
};
struct EpiRes {
    static constexpr bool PERM = true;
    bf16* X; const float* gate; float* slab;
    __device__ __forceinline__ void operator()(AccRef acc, const pg8::Unit& u, int wr, int wc, int fr, int fq) const {
        const int row0 = u.pm * 256 + wr * 64 + fr, col0 = u.pn * 256 + wc * 32 + 8 * fq;
        if (u.atomic) {
            float* sl = slab + (size_t)(u.atomic - 1) * MCTX * 1024;
#pragma unroll
            for (int ai = 0; ai < 2; ++ai)
#pragma unroll
                for (int m = 0; m < 4; ++m) { float* rowp = sl + (size_t)(row0 - MLAT + ai * 128 + m * 16) * 1024 + col0;
#pragma unroll
                    for (int bj = 0; bj < 2; ++bj) { *(f32x4*)(rowp + bj * 128) = acc[ai][bj][m][0]; *(f32x4*)(rowp + bj * 128 + 4) = acc[ai][bj][m][1]; } }
        } else {
            const int rb = u.pm * 256; const int bidx = rb < MLAT ? (rb >> 12) : 8;
            const float* gp = gate + (size_t)bidx * 6144 + col0;
            f32x4 gv[2][2];
#pragma unroll
            for (int bj = 0; bj < 2; ++bj)
#pragma unroll
                for (int n = 0; n < 2; ++n) gv[bj][n] = *(const f32x4*)(gp + bj * 128 + n * 4);
            v4u xr[2][4][2];
#pragma unroll
            for (int ai = 0; ai < 2; ++ai)
#pragma unroll
                for (int m = 0; m < 4; ++m) { const bf16* rowp = X + (size_t)(row0 + ai * 128 + m * 16) * 1024 + col0;
#pragma unroll
                    for (int bj = 0; bj < 2; ++bj) xr[ai][m][bj] = *(const v4u*)(rowp + bj * 128); }
#pragma unroll
            for (int ai = 0; ai < 2; ++ai)
#pragma unroll
                for (int m = 0; m < 4; ++m) { bf16* rowp = X + (size_t)(row0 + ai * 128 + m * 16) * 1024 + col0;
#pragma unroll
                    for (int bj = 0; bj < 2; ++bj) { const v4u x = xr[ai][m][bj];
                        const f32x4 x0 = {bflo(x.x), bfhi(x.x), bflo(x.y), bfhi(x.y)}, x1 = {bflo(x.z), bfhi(x.z), bflo(x.w), bfhi(x.w)};
                        *(v4u*)(rowp + bj * 128) = pack8(x0 + gv[bj][0] * acc[ai][bj][m][0], x1 + gv[bj][1] * acc[ai][bj][m][1]); } }
        }
    }
};
struct EpiSwiGlu {
    static constexpr bool PERM = true;
    bf16* O; int ldo; int row_sub; int blocked;
    __device__ __forceinline__ void operator()(AccRef acc, const pg8::Unit& u, int wr, int wc, int fr, int fq) const {
        const int row0 = u.pm * 256 - row_sub + wr * 64 + fr, c0 = u.pn * 128 + wc * 32 + 8 * fq;
#pragma unroll
        for (int ai = 0; ai < 2; ++ai)
#pragma unroll
            for (int m = 0; m < 4; ++m) {
                f32x4 a0 = acc[ai][0][m][0], a1 = acc[ai][0][m][1]; const f32x4 b0 = acc[ai][1][m][0], b1 = acc[ai][1][m][1];
#pragma unroll
                for (int j = 0; j < 4; ++j) { a0[j] = siluf_(a0[j]) * b0[j]; a1[j] = siluf_(a1[j]) * b1[j]; }
                const int row = row0 + ai * 128 + m * 16;
                bf16* p = blocked ? O + ((size_t)((row >> 8) * (ldo >> 6) + (c0 >> 6)) * 256 + (row & 255)) * 64 + (c0 & 63) : O + (size_t)row * ldo + c0;
                st16_wt(p, pack8(a0, a1));
            }
    }
};
struct EpiPlain {
    static constexpr bool PERM = true;
    bf16* O; int ldo; bf16* O2; int xpm0;
    __device__ __forceinline__ void operator()(AccRef acc, const pg8::Unit& u, int wr, int wc, int fr, int fq) const {
        const int rt = wr * 64 + fr, ct = wc * 32 + 8 * fq;
        bf16* base; int ld;
        if (u.atomic == 2) { base = O2 + (size_t)((u.pm - xpm0) * 4 + u.pn) * 65536 + (size_t)rt * 256 + ct; ld = 256; }
        else { base = O + (size_t)(u.pm * 256 + rt) * ldo + u.pn * 256 + ct; ld = ldo; }
#pragma unroll
        for (int ai = 0; ai < 2; ++ai)
#pragma unroll
            for (int m = 0; m < 4; ++m)
#pragma unroll
                for (int bj = 0; bj < 2; ++bj)
                    *(v4u*)(base + (size_t)(ai * 128 + m * 16) * ld + bj * 128) = pack8(acc[ai][bj][m][0], acc[ai][bj][m][1]);
    }
};

#define XB_TMO      128
#define XB_XCNT(j)  (256  + 64 * (j))
#define XB_XSUB(j)  (1280 + 64 * (j))
#define XB_XGEN(j)  (2304 + 64 * (j))
#define XB_TOP      3328
#define XB_TOPGEN   3392
#define XCD_BAR_WORDS 3456
#define XB_SPIN_CAP (1u << 18)
__device__ __forceinline__ unsigned xb_ld(unsigned* p)              { return __hip_atomic_load(p, __ATOMIC_RELAXED, __HIP_MEMORY_SCOPE_AGENT); }
__device__ __forceinline__ unsigned xb_add(unsigned* p, unsigned v) { return __hip_atomic_fetch_add(p, v, __ATOMIC_RELAXED, __HIP_MEMORY_SCOPE_AGENT); }
__device__ __forceinline__ unsigned xb_xcc_id() { return (unsigned)__builtin_amdgcn_s_getreg((3 << 11) | 20) & 0xFu; }
#define XB_SPIN(cond, bar) do { unsigned _sp = 0; while (cond) { __builtin_amdgcn_s_sleep(1); \
    if ((++_sp & 255u) == 0u) { if (xb_ld(&(bar)[XB_TMO])) break; if (_sp > XB_SPIN_CAP) { atomicAdd(&(bar)[XB_TMO], 1u); break; } } } } while (0)
struct XcdBarrier { unsigned* bar; unsigned x; volatile LAS unsigned* st; };
__device__ __forceinline__ XcdBarrier xcd_barrier_post(unsigned* bar, volatile LAS unsigned* st) {
    XcdBarrier b; b.bar = bar; b.x = xb_xcc_id(); b.st = st;
    if (threadIdx.x == 0) (void)xb_add(&bar[XB_XCNT(b.x)], 1u);
    return b;
}
__device__ __forceinline__ void xcd_barrier_complete(unsigned* bar, unsigned x, unsigned& nloc, unsigned& nx) {
    const unsigned G = gridDim.x * gridDim.y * gridDim.z;
    unsigned sum, cnt, mine, sp = 0u;
    for (;;) {
        sum = 0u; cnt = 0u; mine = 0u;
#pragma unroll
        for (unsigned j = 0; j < 16; ++j) { const unsigned c = xb_ld(&bar[XB_XCNT(j)]); sum += c; cnt += (c > 0u) ? 1u : 0u; mine = (j == x) ? c : mine; }
        if (sum == G) break;
        __builtin_amdgcn_s_sleep(1);
        if ((++sp & 255u) == 0u) { if (xb_ld(&bar[XB_TMO])) break; if (sp > XB_SPIN_CAP) { atomicAdd(&bar[XB_TMO], 1u); break; } }
    }
    nloc = mine > 0u ? mine : 1u; nx = cnt > 0u ? cnt : 1u;
}
__device__ __forceinline__ void xcd_barrier(const XcdBarrier& b) {
    asm volatile("s_waitcnt vmcnt(0)" ::: "memory");
    __syncthreads();
    if (lt_tid() == 0) {
        unsigned* bar = b.bar;
        __builtin_amdgcn_s_waitcnt(0);
        unsigned nloc = b.st[0], nx = b.st[1];
        if (nloc == 0u) { xcd_barrier_complete(bar, b.x, nloc, nx); b.st[0] = nloc; b.st[1] = nx; }
        const unsigned old = xb_add(&bar[XB_XSUB(b.x)], 1u);
        const unsigned gen = old / nloc;
        if (old + 1u == (gen + 1u) * nloc) {
            __builtin_amdgcn_fence(__ATOMIC_RELEASE, "agent");
            asm volatile("s_waitcnt vmcnt(0)" ::: "memory");
            const unsigned og = xb_add(&bar[XB_TOP], 1u);
            const unsigned tg = og / nx;
            if (og + 1u == (tg + 1u) * nx) xb_add(&bar[XB_TOPGEN], 1u);
            else XB_SPIN(xb_ld(&bar[XB_TOPGEN]) == tg, bar);
            __builtin_amdgcn_fence(__ATOMIC_ACQUIRE, "agent");
            xb_add(&bar[XB_XGEN(b.x)], 1u);
            asm volatile("s_waitcnt vmcnt(0)" ::: "memory");
        } else {
            XB_SPIN(xb_ld(&bar[XB_XGEN(b.x)]) == gen, bar);
            __builtin_amdgcn_fence(__ATOMIC_ACQUIRE, "agent");
            asm volatile("s_waitcnt vmcnt(0)" ::: "memory");
        }
    }
    __syncthreads();
}

struct XbTok { unsigned gen, tg; int role; };
__device__ __forceinline__ XbTok xcd_arrive(const XcdBarrier& b) {
    asm volatile("s_waitcnt vmcnt(0)" ::: "memory");
    __syncthreads();
    XbTok t; t.gen = 0u; t.tg = 0u; t.role = 0;
    if (lt_tid() == 0) {
        unsigned* bar = b.bar;
        __builtin_amdgcn_s_waitcnt(0);
        unsigned nloc = b.st[0], nx = b.st[1];
        if (nloc == 0u) { xcd_barrier_complete(bar, b.x, nloc, nx); b.st[0] = nloc; b.st[1] = nx; }
        const unsigned old = xb_add(&bar[XB_XSUB(b.x)], 1u);
        t.gen = old / nloc;
        if (old + 1u == (t.gen + 1u) * nloc) {
            __builtin_amdgcn_fence(__ATOMIC_RELEASE, "agent");
            asm volatile("s_waitcnt vmcnt(0)" ::: "memory");
            const unsigned og = xb_add(&bar[XB_TOP], 1u);
            t.tg = og / nx;
            if (og + 1u == (t.tg + 1u) * nx) { xb_add(&bar[XB_TOPGEN], 1u); t.role = 2; } else t.role = 1;
        }
    }
    return t;
}
__device__ __forceinline__ void xcd_wait(const XcdBarrier& b, const XbTok& t) {
    if (lt_tid() == 0) {
        unsigned* bar = b.bar;
        if (t.role) {
            if (t.role == 1) XB_SPIN(xb_ld(&bar[XB_TOPGEN]) == t.tg, bar);
            __builtin_amdgcn_fence(__ATOMIC_ACQUIRE, "agent");
            xb_add(&bar[XB_XGEN(b.x)], 1u);
            asm volatile("s_waitcnt vmcnt(0)" ::: "memory");
        } else {
            XB_SPIN(xb_ld(&bar[XB_XGEN(b.x)]) == t.gen, bar);
            __builtin_amdgcn_fence(__ATOMIC_ACQUIRE, "agent");
            asm volatile("s_waitcnt vmcnt(0)" ::: "memory");
        }
    }
    __syncthreads();
}

struct Args { const float* in[29]; float* out; unsigned char* ws; int ph_lo, ph_hi; };
enum InIdx { I_X = 0, I_C, I_CTX, I_CCTX, I_WMOD, I_BMOD, I_GMIX, I_GFFN, I_WIN, I_WOUT, I_ARE, I_AIM, I_LOGSTEP, I_BRE, I_BIM, I_CRE, I_CIM, I_SSMD, I_GLUW, I_GLUB, I_RPB,
             I_FW1, I_FW3, I_FW2, I_ROUTER, I_MW1, I_MW3, I_MW2, I_GFINAL };
struct Ctx {
    LAS unsigned char* lds; unsigned char* ws; gu32* ctl;
    int tid, lane, wave, vcu, G;
    const float* const __attribute__((address_space(4)))* in; float* out;
};
__device__ __forceinline__ int batch_slot(int m) { return m < MLAT ? (m >> 12) : 8; }

__device__ __forceinline__ void mod_phase(Ctx& F) {
    F.tid = lt_tid(); F.lane = F.tid & 63;
    LAS float* sc = (LAS float*)F.lds;
    LAS float* red = sc + 9 * 1024;
    const float* c = F.in[I_C]; const float* cc = F.in[I_CCTX];
    for (int i = F.tid; i < 9 * 1024; i += 512) { const float v = i < 8192 ? c[i] : cc[i - 8192]; sc[i] = siluf_(v); }
    __syncthreads();
    float* mod = (float*)(F.ws + WS_MOD);
    const int col = F.tid & 31, kg = F.tid >> 5;
    for (int it = F.vcu; it < 4 * 192; it += F.G) {
        const int l = it / 192, c0 = (it % 192) * 32;
        const float* W = F.in[I_WMOD] + (size_t)l * 1024 * 6144 + c0 + col;
        float acc[9];
#pragma unroll
        for (int r = 0; r < 9; ++r) acc[r] = 0.f;
#pragma unroll 4
        for (int kk = 0; kk < 64; ++kk) { const int k = kg * 64 + kk; const float w = __builtin_nontemporal_load(W + (size_t)k * 6144);
#pragma unroll
            for (int r = 0; r < 9; ++r) acc[r] += sc[r * 1024 + k] * w; }
#pragma unroll
        for (int r = 0; r < 9; ++r) red[(kg * 9 + r) * 32 + col] = acc[r];
        __syncthreads();
        if (F.tid < 288) { const int r = F.tid >> 5; float s = F.in[I_BMOD][l * 6144 + c0 + col];
#pragma unroll
            for (int q = 0; q < 16; ++q) s += red[(q * 9 + r) * 32 + col];
            mod[((size_t)l * 9 + r) * 6144 + c0 + col] = s; }
        __syncthreads();
    }
}

__device__ __forceinline__ void tr_item(const float* W, int K, int N, bf16* WT, int mode, LAS float* scr, int item, int lane, int ldk = 0) {
    if (ldk == 0) ldk = K;
    const int nblk = N / 64, kb = item / nblk, nb = item % nblk, k0 = 64 * kb, n0 = 64 * nb;
    const int drow0 = mode == 0 ? n0 : ((n0 >> 7) * 256 + (mode == 2 ? 128 : 0) + (n0 & 127));
    const float* src = W + (size_t)(k0 + (lane >> 4)) * N + n0 + 4 * (lane & 15);
    f32x4 v[16];
#pragma unroll
    for (int i = 0; i < 16; ++i) v[i] = __builtin_nontemporal_load((const GAS f32x4*)(src + (size_t)(4 * i) * N));
#pragma unroll
    for (int i = 0; i < 16; ++i) { LAS float* d = scr + (4 * i + (lane >> 4)) * 65 + 4 * (lane & 15); d[0] = v[i][0]; d[1] = v[i][1]; d[2] = v[i][2]; d[3] = v[i][3]; }
    LDS_WAIT(); asm volatile("" ::: "memory");
    const int c = lane & 7;
#pragma unroll
    for (int j = 0; j < 8; ++j) { const int n = (lane >> 3) + 8 * j; const LAS float* s = scr + (8 * c) * 65 + n;
        v4u o; o.x = pk2(s[0 * 65], s[1 * 65]); o.y = pk2(s[2 * 65], s[3 * 65]); o.z = pk2(s[4 * 65], s[5 * 65]); o.w = pk2(s[6 * 65], s[7 * 65]);
        __builtin_nontemporal_store(o, (GAS v4u*)(WT + (size_t)(drow0 + n) * ldk + k0 + 8 * c)); }
    LDS_WAIT(); asm volatile("" ::: "memory");
}
constexpr int CV_IN = 16 * 32, CV_OUT = 16 * 16, CV_GLU = 8 * 8, CV_D13 = 16 * 44, CV_D2 = 44 * 16, CV_M13 = 16 * 56, CV_M2 = 56 * 16;
__device__ __forceinline__ int conv_ntiles(int l) { return CV_IN + CV_OUT + CV_GLU + ((l & 1) ? 8 * (2 * CV_M13 + CV_M2) : (2 * CV_D13 + CV_D2)); }
__device__ __forceinline__ void conv_tile(Ctx& F, int l, int r, LAS float* scr, int lane) {
    const bool moe = (l & 1) != 0; const int li = l >> 1;
    bf16* W13 = (bf16*)(F.ws + ws_w13(l)); bf16* W2 = (bf16*)(F.ws + ws_w2(l));
    if (r < CV_IN) { tr_item(F.in[I_WIN] + (size_t)l * 1024 * 2048, 1024, 2048, (bf16*)(F.ws + ws_win(l)), 0, scr, r, lane); return; } r -= CV_IN;
    if (r < CV_OUT) { tr_item(F.in[I_WOUT] + (size_t)l * 1024 * 1024, 1024, 1024, (bf16*)(F.ws + ws_wout(l)), 0, scr, r, lane); return; } r -= CV_OUT;
    if (r < CV_GLU) { tr_item(F.in[I_GLUW] + (size_t)l * 512 * 512, 512, 512, (bf16*)(F.ws + ws_wglu(l)), 0, scr, r, lane); return; } r -= CV_GLU;
    if (!moe) {
        if (r < CV_D13) { tr_item(F.in[I_FW1] + (size_t)li * 1024 * DFF, 1024, DFF, W13, 1, scr, r, lane); return; } r -= CV_D13;
        if (r < CV_D13) { tr_item(F.in[I_FW3] + (size_t)li * 1024 * DFF, 1024, DFF, W13, 2, scr, r, lane); return; } r -= CV_D13;
        tr_item(F.in[I_FW2] + (size_t)li * DFF * 1024, DFF, 1024, W2, 0, scr, r, lane, DW2_LD);
    } else {
        const int per = 2 * CV_M13 + CV_M2, e = r / per; r -= e * per;
        const size_t eo = (size_t)(li * 8 + e) * 1024 * DFE;
        if (r < CV_M13) { tr_item(F.in[I_MW1] + eo, 1024, DFE, W13 + (size_t)e * 7168 * 1024, 1, scr, r, lane); return; } r -= CV_M13;
        if (r < CV_M13) { tr_item(F.in[I_MW3] + eo, 1024, DFE, W13 + (size_t)e * 7168 * 1024, 2, scr, r, lane); return; } r -= CV_M13;
        tr_item(F.in[I_MW2] + eo, DFE, 1024, W2 + (size_t)e * 1024 * DFE, 0, scr, r, lane);
    }
}
__device__ __forceinline__ void wconv_drain(Ctx& F, int l, unsigned x) {
    volatile LAS int* bc = (volatile LAS int*)(F.lds + LDSCTL_OFF + 512);
    const int n = conv_ntiles(l);
    for (int rr = 0; rr < 8; ++rr) {
        const int r = (rr + (int)(x & 7u)) & 7;
        for (;;) {
            __syncthreads();
            if (threadIdx.x == 0) { gu32* q = F.ctl + CW_Q + 64 * (l * 8 + r); int c = 0x7fffff;
                if ((int)((__hip_atomic_load(q, RLX_AGENT) * 8u + (unsigned)r) * 8u) < n) c = (int)__hip_atomic_fetch_add(q, 1u, RLX_AGENT);
                bc[0] = c; }
            __syncthreads();
            const int t = (bc[0] * 8 + r) * 8 + F.wave;
            if ((bc[0] * 8 + r) * 8 >= n) break;
            if (t < n) conv_tile(F, l, t, (LAS float*)(F.lds + F.wave * 16640), lt_tid() & 63);
        }
    }
}
__device__ __forceinline__ void wconv_phase(Ctx& F, int l, int t_begin) {
    const int lane = lt_tid() & 63;
    LAS float* scr = (LAS float*)(F.lds + F.wave * 16640);
    const int gw = F.vcu * 8 + F.wave, NGW = F.G * 8, n = conv_ntiles(l);
    for (int it = t_begin + gw; it < n; it += NGW) conv_tile(F, l, it, scr, lane);
}

__device__ __forceinline__ void sincos_red(float x, float& s, float& c) {
    const float k = rintf(x * 0.15915494309189535f);
    float r = fmaf(-k, 6.28318548202514648f, x); r = fmaf(-k, -1.7484555e-07f, r);
    s = __sinf(r); c = __cosf(r);
}
#define CCI(dir, hh, p) ((((dir) * 16 + (hh)) * 65 + (p)) * 2)
#define KTI(dir, tau, hh, h) (((((dir) * 16 + (hh)) * 16 + (h)) * 32) + (tau))
__device__ __forceinline__ void ssm_prepA(Ctx& F, int l, int g, int part8) {
    F.tid = lt_tid(); F.lane = F.tid & 63;
    LAS float* LAM = (LAS float*)F.lds;
    LAS float* CC = LAM + 8448;
    LAS float* BB = CC + 4160;
    const int tid = F.tid;
    __syncthreads();
    if (tid < 128) {
        const int dir = tid >> 6, p = tid & 63; const int pi = ((l * 2 + dir) * 32 + g) * 64 + p;
        const float are = fminf(F.in[I_ARE][pi], -1e-4f), aim = F.in[I_AIM][pi];
        const float dt = __expf(F.in[I_LOGSTEP][(l * 2 + dir) * 32 + g]);
        const float th = aim * dt, ad = are * dt;
        for (int e = 0; e <= 32; ++e) { float sn, cs; sincos_red(th * (float)e, sn, cs); const float mg = __expf(ad * (float)e);
            LAM[((dir * 64 + p) * 33 + e) * 2] = mg * cs; LAM[((dir * 64 + p) * 33 + e) * 2 + 1] = mg * sn; }
        float s1, c1; sincos_red(th, s1, c1); const float m1 = __expf(ad); const float lre = m1 * c1, lim = m1 * s1;
        const float den = are * are + aim * aim;
        const float zre = ((lre - 1.f) * are + lim * aim) / den, zim = (lim * are - (lre - 1.f) * aim) / den;
        for (int h = 0; h < 16; ++h) { const float br = F.in[I_BRE][(size_t)pi * 16 + h], bi = F.in[I_BIM][(size_t)pi * 16 + h];
            BB[((dir * 64 + p) * 16 + h) * 2] = zre * br - zim * bi; BB[((dir * 64 + p) * 16 + h) * 2 + 1] = zre * bi + zim * br; }
    }
    for (int idx = tid; idx < 2048; idx += 512) { const int dir = idx >> 10, rem = idx & 1023, hh = rem >> 6, p = rem & 63; const size_t gi = ((size_t)((l * 2 + dir) * 32 + g)) * 1024 + rem;
        CC[CCI(dir, hh, p)] = F.in[I_CRE][gi]; CC[CCI(dir, hh, p) + 1] = F.in[I_CIM][gi]; }
    __syncthreads();
    {
        const int dir = tid >> 8, hh = (tid >> 4) & 15, h = tid & 15, t0 = 4 * part8;
        float a0 = 0.f, a1 = 0.f, a2 = 0.f, a3 = 0.f;
        for (int p = 0; p < 64; ++p) {
            const float cr = CC[CCI(dir, hh, p)], ci = CC[CCI(dir, hh, p) + 1];
            const float br = BB[((dir * 64 + p) * 16 + h) * 2], bi = BB[((dir * 64 + p) * 16 + h) * 2 + 1];
            const float gr = cr * br - ci * bi, gi = cr * bi + ci * br;
            const LAS float* lp = LAM + ((dir * 64 + p) * 33 + t0) * 2;
            a0 += gr * lp[0] - gi * lp[1]; a1 += gr * lp[2] - gi * lp[3]; a2 += gr * lp[4] - gi * lp[5]; a3 += gr * lp[6] - gi * lp[7];
        }
        float* KTG = (float*)(F.ws + WS_KTG) + (size_t)g * 16384;
        *(f32x4*)(KTG + KTI(dir, t0, hh, h)) = (f32x4){a0, a1, a2, a3};
    }
    bf16* BtS = (bf16*)(F.ws + WS_BTS) + (size_t)g * 256 * 512;
    bf16* BtY = (bf16*)(F.ws + WS_BTY) + (size_t)g * 512 * KY;
    for (int task = tid; task < 32 * 32; task += 512) {
        const int n = part8 * 32 + (task >> 5), s = task & 31, dir = n >> 7, part = (n >> 6) & 1, p = n & 63, e = dir ? s : 31 - s;
        const float lr = LAM[((dir * 64 + p) * 33 + e) * 2], li = LAM[((dir * 64 + p) * 33 + e) * 2 + 1];
        float v[16];
#pragma unroll
        for (int h = 0; h < 16; ++h) { const float br = BB[((dir * 64 + p) * 16 + h) * 2], bi = BB[((dir * 64 + p) * 16 + h) * 2 + 1]; v[h] = part ? (lr * bi + li * br) : (lr * br - li * bi); }
        v4u o0, o1; o0.x = pk2(v[0], v[1]); o0.y = pk2(v[2], v[3]); o0.z = pk2(v[4], v[5]); o0.w = pk2(v[6], v[7]); o1.x = pk2(v[8], v[9]); o1.y = pk2(v[10], v[11]); o1.z = pk2(v[12], v[13]); o1.w = pk2(v[14], v[15]);
        v4u* dst = (v4u*)(BtS + (size_t)n * 512 + s * 16); dst[0] = o0; dst[1] = o1;
    }
    for (int task = tid; task < 64 * 16; task += 512) {
        const int n = part8 * 64 + (task >> 4), ch = task & 15, t = n >> 4, hh = n & 15, dir = ch >> 3, part = (ch >> 2) & 1, p0 = (ch & 3) * 16, e = dir ? 32 - t : t + 1;
        float v[16];
#pragma unroll
        for (int j = 0; j < 16; ++j) { const int p = p0 + j; const float cr = CC[CCI(dir, hh, p)], ci = CC[CCI(dir, hh, p) + 1];
            const float lr = LAM[((dir * 64 + p) * 33 + e) * 2], li = LAM[((dir * 64 + p) * 33 + e) * 2 + 1]; v[j] = part ? -(cr * li + ci * lr) : (cr * lr - ci * li); }
        v4u o0, o1; o0.x = pk2(v[0], v[1]); o0.y = pk2(v[2], v[3]); o0.z = pk2(v[4], v[5]); o0.w = pk2(v[6], v[7]); o1.x = pk2(v[8], v[9]); o1.y = pk2(v[10], v[11]); o1.z = pk2(v[12], v[13]); o1.w = pk2(v[14], v[15]);
        v4u* dst = (v4u*)(BtY + (size_t)n * KY + 512 + ch * 16); dst[0] = o0; dst[1] = o1;
    }
    __syncthreads();
}
__device__ __forceinline__ void ssm_prepB(Ctx& F, int l, int g, int part8) {
    F.tid = lt_tid(); F.lane = F.tid & 63;
    LAS float* KT = (LAS float*)F.lds;
    const int tid = F.tid;
    __syncthreads();
    const float* KTG = (const float*)(F.ws + WS_KTG) + (size_t)g * 16384;
    for (int i = tid; i < 4096; i += 512) *(LAS f32x4*)(KT + 4 * i) = *(const f32x4*)(KTG + 4 * i);
    __syncthreads();
    bf16* BtY = (bf16*)(F.ws + WS_BTY) + (size_t)g * 512 * KY;
    const float* dsk = F.in[I_SSMD] + l * 512 + g * 16;
    for (int task = tid; task < 64 * 32; task += 512) {
        const int n = part8 * 64 + (task >> 5), s = task & 31, t = n >> 4, hh = n & 15;
        float v[16];
#pragma unroll
        for (int h = 0; h < 16; ++h) { float x = 0.f; if (s <= t) x += KT[KTI(0, t - s, hh, h)]; if (s >= t) x += KT[KTI(1, s - t, hh, h)]; if (s == t && h == hh) x += dsk[hh]; v[h] = x; }
        v4u o0, o1; o0.x = pk2(v[0], v[1]); o0.y = pk2(v[2], v[3]); o0.z = pk2(v[4], v[5]); o0.w = pk2(v[6], v[7]); o1.x = pk2(v[8], v[9]); o1.y = pk2(v[10], v[11]); o1.z = pk2(v[12], v[13]); o1.w = pk2(v[14], v[15]);
        v4u* dst = (v4u*)(BtY + (size_t)n * KY + s * 16); dst[0] = o0; dst[1] = o1;
    }
    __syncthreads();
}
#undef CCI
#undef KTI

__device__ __forceinline__ void moe_seg(const unsigned* cnt, int (&segp)[9]) {
    int acc = 0;
#pragma unroll
    for (int e = 0; e < 8; ++e) { segp[e] = acc; acc += ((int)cnt[e] + 255) >> 8; }
    segp[8] = acc;
}
template <int MODE>
__device__ __forceinline__ void norm_phase(Ctx& F, int l, int M, bool src_in, bool combine, bool router, const float* slab_gate, int nparts) {
    F.tid = lt_tid(); F.lane = F.tid & 63;
    const int gw = F.vcu * 8 + F.wave, NGW = F.G * 8, lane = F.lane;
    bf16* X = (bf16*)(F.ws + WS_X); bf16* HB = (bf16*)(F.ws + ((MODE == 1 && router) ? WS_XS : WS_HB));
    const float* mod = (const float*)(F.ws + WS_MOD);
    const float* gain = MODE == 0 ? F.in[I_GMIX] + l * 1024 : (MODE == 1 ? F.in[I_GFFN] + l * 1024 : F.in[I_GFINAL]);
    const int* route_e = (const int*)(F.ws + WS_ROUTE); const f32x2* route_g = (const f32x2*)(F.ws + WS_ROUTE + 256 * 1024); const int* slot_of = (const int*)(F.ws + WS_ROUTE + 576 * 1024);
    int* route_e_w = (int*)(F.ws + WS_ROUTE); f32x2* route_g_w = (f32x2*)(F.ws + WS_ROUTE + 256 * 1024);
    const bf16* YS = (const bf16*)(F.ws + WS_YS); const bf16* YS2 = (const bf16*)(F.ws + WS_SLAB);
    int m2_pm0 = -1;
    if (combine && MK_SPLIT_M2) { int segp_[9]; moe_seg((const unsigned*)F.ctl + CW_CNT + ((l - 1) >> 1) * 16, segp_); const int P_ = segp_[8], Pm_ = (P_ >> 6) << 6, xl_ = P_ - Pm_; if (xl_ > 0 && xl_ <= 32 && F.G == 256) m2_pm0 = Pm_; }
    LAS int* lcnt = (LAS int*)(F.lds);
    float rw[4][4][8];
    if (router) {
        if (F.tid < 8) lcnt[F.tid] = 0;
        __syncthreads();
        const float* R = F.in[I_ROUTER] + (size_t)(l >> 1) * 1024 * 8;
#pragma unroll
        for (int j = 0; j < 4; ++j)
#pragma unroll
            for (int i = 0; i < 4; ++i) { const f32x4 a = *(const f32x4*)(R + (size_t)(256 * j + 4 * lane + i) * 8), b = *(const f32x4*)(R + (size_t)(256 * j + 4 * lane + i) * 8 + 4);
                rw[j][i][0] = a[0]; rw[j][i][1] = a[1]; rw[j][i][2] = a[2]; rw[j][i][3] = a[3]; rw[j][i][4] = b[0]; rw[j][i][5] = b[1]; rw[j][i][6] = b[2]; rw[j][i][7] = b[3]; }
    }
    LAS float* t_gain = (LAS float*)(F.lds + 1024); LAS float* t_mod = t_gain + 1024; LAS float* t_gt = t_mod + 9 * 2048; LAS float* t_sg = t_gt + 9 * 1024;
    __syncthreads();
    for (int i = F.tid; i < 256; i += 512) ((LAS f32x4*)t_gain)[i] = *(const f32x4*)(gain + 4 * i);
    if (MODE != 2) for (int i = F.tid; i < 9 * 512; i += 512) { const int bs_ = i >> 9, o_ = (i & 511) * 4; ((LAS f32x4*)t_mod)[i] = *(const f32x4*)(mod + ((size_t)l * 9 + bs_) * 6144 + (MODE == 0 ? 0 : 3 * 1024) + o_); }
    if (combine) for (int i = F.tid; i < 9 * 256; i += 512) { const int bs_ = i >> 8, o_ = (i & 255) * 4; ((LAS f32x4*)t_gt)[i] = *(const f32x4*)(mod + ((size_t)(l - 1) * 9 + bs_) * 6144 + 5 * 1024 + o_); }
    if (slab_gate != nullptr) for (int i = F.tid; i < 256; i += 512) ((LAS f32x4*)t_sg)[i] = *(const f32x4*)(slab_gate + 4 * i);
    __syncthreads();
    v2u xq[4][4]; f32x4 vq[1][4]; v2u y0q[2][4], y1q[2][4]; int s0q[4], s1q[4]; f32x2 ggq[4];
#pragma unroll
    for (int u = 0; u < 2; ++u)
#pragma unroll
        for (int j = 0; j < 4; ++j) { xq[u][j] = (v2u){0u, 0u}; xq[u + 2][j] = (v2u){0u, 0u}; vq[0][j] = (f32x4){0.f, 0.f, 0.f, 0.f}; y0q[u][j] = (v2u){0u, 0u}; y1q[u][j] = (v2u){0u, 0u}; }
#pragma unroll
    for (int u = 0; u < 4; ++u) { s0q[u] = 0; s1q[u] = 0; ggq[u] = (f32x2){0.f, 0.f}; }
#define NORM_REQS(u_, mm) do { const int m_ = (mm); if (combine && m_ < M) { s0q[u_] = slot_of[2 * m_]; s1q[u_] = slot_of[2 * m_ + 1]; ggq[u_] = route_g[m_]; } } while (0)
#define NORM_REQV(u_, mm) do { const int m_ = (mm); if (src_in && m_ < M) { const float* srow_ = m_ < MLAT ? F.in[I_X] + (size_t)m_ * 1024 : F.in[I_CTX] + (size_t)(m_ - MLAT) * 1024; \
            _Pragma("unroll") for (int j = 0; j < 4; ++j) vq[u_][j] = __builtin_nontemporal_load((const f32x4*)(srow_ + 256 * j + 4 * lane)); } } while (0)
#define NORM_REQX(u_, mm) do { const int m_ = (mm); if (!src_in && m_ < M) { \
            _Pragma("unroll") for (int j = 0; j < 4; ++j) xq[u_][j] = *(const v2u*)(X + (size_t)m_ * 1024 + 256 * j + 4 * lane); } } while (0)
#define NORM_REQY(u_, su_, mm) do { if (combine && (mm) < M) { \
        _Pragma("unroll") for (int j = 0; j < 4; ++j) { y0q[u_][j] = __builtin_nontemporal_load((const v2u*)(YS + (size_t)s0q[su_] * 1024 + 256 * j + 4 * lane)); y1q[u_][j] = __builtin_nontemporal_load((const v2u*)(YS + (size_t)s1q[su_] * 1024 + 256 * j + 4 * lane)); } } } while (0)
#pragma unroll
    for (int u = 0; u < 4; ++u) NORM_REQS(u, gw + u * NGW);
    NORM_REQV(0, gw);
#pragma unroll
    for (int u = 0; u < 4; ++u) NORM_REQX(u, gw + u * NGW);
    NORM_REQY(0, 0, gw); NORM_REQY(1, 1, gw + NGW);
    for (int m0 = gw; m0 < M; m0 += 4 * NGW) {
#pragma unroll
        for (int u = 0; u < 4; ++u) {
            const int m = m0 + u * NGW;
            if (m < M) {
                const int bs = batch_slot(m);
                f32x4 v[4];
                if (src_in) {
#pragma unroll
                    for (int j = 0; j < 4; ++j) v[j] = vq[0][j];
                } else {
#pragma unroll
                    for (int j = 0; j < 4; ++j) v[j] = (f32x4){bflo(xq[u][j].x), bfhi(xq[u][j].x), bflo(xq[u][j].y), bfhi(xq[u][j].y)};
                }
                const int s0 = s0q[u], s1 = s1q[u]; const f32x2 gg = ggq[u];
                v2u y0r[4], y1r[4];
#pragma unroll
                for (int j = 0; j < 4; ++j) { y0r[j] = y0q[u & 1][j]; y1r[j] = y1q[u & 1][j]; }
                v2u y0b[4], y1b[4]; bool sp0 = false, sp1 = false;
                if (combine) {
                    sp0 = m2_pm0 >= 0 && (s0 >> 8) >= m2_pm0; sp1 = m2_pm0 >= 0 && (s1 >> 8) >= m2_pm0;
                    if (sp0) {
#pragma unroll
                        for (int j = 0; j < 4; ++j) y0b[j] = *(const v2u*)(YS2 + (size_t)(((s0 >> 8) - m2_pm0) * 4 + j) * 65536 + (size_t)(s0 & 255) * 256 + 4 * lane);
                    }
                    if (sp1) {
#pragma unroll
                        for (int j = 0; j < 4; ++j) y1b[j] = *(const v2u*)(YS2 + (size_t)(((s1 >> 8) - m2_pm0) * 4 + j) * 65536 + (size_t)(s1 & 255) * 256 + 4 * lane);
                    }
                }
                const bool addslab = slab_gate != nullptr && m >= MLAT;
                f32x4 sla[4];
                if (addslab) {
                    const float* sl = (const float*)(F.ws + WS_SLAB) + (size_t)(m - MLAT) * 1024;
#pragma unroll
                    for (int j = 0; j < 4; ++j) { f32x4 a = *(const f32x4*)(sl + 256 * j + 4 * lane);
                        for (int p = 1; p < nparts; ++p) a = a + *(const f32x4*)(sl + (size_t)p * MCTX * 1024 + 256 * j + 4 * lane);
                        sla[j] = a; }
                }
                NORM_REQY(u & 1, (u + 2) & 3, m + 2 * NGW);
                NORM_REQV(0, m + NGW);
                NORM_REQX(u, m + 4 * NGW);
                NORM_REQS(u, m + 4 * NGW);
                if (combine) {
                    const LAS float* gt2 = t_gt + bs * 1024;
#pragma unroll
                    for (int j = 0; j < 4; ++j) { const v2u y0 = y0r[j], y1 = y1r[j];
                        const f32x4 gt = *(const LAS f32x4*)(gt2 + 256 * j + 4 * lane);
                        f32x4 f; f[0] = gg[0] * bflo(y0.x) + gg[1] * bflo(y1.x); f[1] = gg[0] * bfhi(y0.x) + gg[1] * bfhi(y1.x); f[2] = gg[0] * bflo(y0.y) + gg[1] * bflo(y1.y); f[3] = gg[0] * bfhi(y0.y) + gg[1] * bfhi(y1.y);
                        if (sp0) { f[0] += gg[0] * bflo(y0b[j].x); f[1] += gg[0] * bfhi(y0b[j].x); f[2] += gg[0] * bflo(y0b[j].y); f[3] += gg[0] * bfhi(y0b[j].y); }
                        if (sp1) { f[0] += gg[1] * bflo(y1b[j].x); f[1] += gg[1] * bfhi(y1b[j].x); f[2] += gg[1] * bflo(y1b[j].y); f[3] += gg[1] * bfhi(y1b[j].y); }
                        v[j] = v[j] + gt * f; }
                }
                if (addslab) {
#pragma unroll
                    for (int j = 0; j < 4; ++j) v[j] = v[j] + *(const LAS f32x4*)(t_sg + 256 * j + 4 * lane) * sla[j];
                }
                if (src_in || combine || addslab) {
#pragma unroll
                    for (int j = 0; j < 4; ++j) { v2u w; w.x = pk2(v[j][0], v[j][1]); w.y = pk2(v[j][2], v[j][3]); *(v2u*)(X + (size_t)m * 1024 + 256 * j + 4 * lane) = w; }
                }
                float ss = 0.f;
#pragma unroll
                for (int j = 0; j < 4; ++j) ss += (v[j][0] * v[j][0] + v[j][1] * v[j][1]) + (v[j][2] * v[j][2] + v[j][3] * v[j][3]);
                const float rstd = 1.0f / sqrtf(wave_sum(ss) * (1.0f / 1024.0f) + NORM_EPS);
                if (MODE == 2) {
#pragma unroll
                    for (int j = 0; j < 4; ++j) { const f32x4 gv = *(const LAS f32x4*)(t_gain + 256 * j + 4 * lane); __builtin_nontemporal_store(v[j] * rstd * gv, (f32x4*)(F.out + (size_t)m * 1024 + 256 * j + 4 * lane)); }
                } else {
                    const LAS float* mb = t_mod + bs * 2048;
                    float lg[8];
#pragma unroll
                    for (int e = 0; e < 8; ++e) lg[e] = 0.f;
#pragma unroll
                    for (int j = 0; j < 4; ++j) { const f32x4 gv = *(const LAS f32x4*)(t_gain + 256 * j + 4 * lane), sh = *(const LAS f32x4*)(mb + 256 * j + 4 * lane), sc = *(const LAS f32x4*)(mb + 1024 + 256 * j + 4 * lane);
                        const f32x4 o = v[j] * rstd * gv * (sc + 1.0f) + sh;
                        v2u w; w.x = pk2(o[0], o[1]); w.y = pk2(o[2], o[3]);
                        *(v2u*)(HB + (size_t)m * 1024 + 256 * j + 4 * lane) = w;
                        if (router) {
#pragma unroll
                            for (int i = 0; i < 4; ++i)
#pragma unroll
                                for (int e = 0; e < 8; ++e) lg[e] += o[i] * rw[j][i][e];
                        }
                    }
                    if (router) {
                        {
                            float a4[4], a2[2], a1;
                            { const bool hi = (lane & 1) != 0;
#pragma unroll
                              for (int e = 0; e < 4; ++e) { const float snd = hi ? lg[e] : lg[e + 4], keep = hi ? lg[e + 4] : lg[e]; a4[e] = keep + __shfl_xor(snd, 1); } }
                            { const bool hi = (lane & 2) != 0;
#pragma unroll
                              for (int e = 0; e < 2; ++e) { const float snd = hi ? a4[e] : a4[e + 2], keep = hi ? a4[e + 2] : a4[e]; a2[e] = keep + __shfl_xor(snd, 2); } }
                            { const bool hi = (lane & 4) != 0; const float snd = hi ? a2[0] : a2[1], keep = hi ? a2[1] : a2[0]; a1 = keep + __shfl_xor(snd, 4); }
                            a1 += __shfl_xor(a1, 8); a1 += __shfl_xor(a1, 16); a1 += __shfl_xor(a1, 32);
#pragma unroll
                            for (int e = 0; e < 8; ++e) lg[e] = __builtin_bit_cast(float, __builtin_amdgcn_readlane(__builtin_bit_cast(int, a1), ((e >> 2) & 1) | (((e >> 1) & 1) << 1) | ((e & 1) << 2)));
                        }
                        int e0 = 0; float v0 = lg[0];
#pragma unroll
                        for (int e = 1; e < 8; ++e) if (lg[e] > v0) { v0 = lg[e]; e0 = e; }
                        int e1 = -1; float v1 = -3.0e38f;
#pragma unroll
                        for (int e = 0; e < 8; ++e) if (e != e0 && lg[e] > v1) { v1 = lg[e]; e1 = e; }
                        const float g0 = 1.0f / (1.0f + __expf(v1 - v0));
                        if (lane == 0) { route_e_w[m] = e0 | (e1 << 8); route_g_w[m] = (f32x2){g0, 1.0f - g0}; __hip_atomic_fetch_add(&lcnt[e0], 1, __ATOMIC_RELAXED, __HIP_MEMORY_SCOPE_WORKGROUP); __hip_atomic_fetch_add(&lcnt[e1], 1, __ATOMIC_RELAXED, __HIP_MEMORY_SCOPE_WORKGROUP);
                            gu32* bc_ = F.ctl + CW_BCNT + ((l >> 1) * 256 + m / (M / F.G)) * 8; (void)__hip_atomic_fetch_add(bc_ + e0, 1u, RLX_AGENT); (void)__hip_atomic_fetch_add(bc_ + e1, 1u, RLX_AGENT); }
                    }
                }
            }
        }
    }
#undef NORM_REQS
#undef NORM_REQX
#undef NORM_REQV
#undef NORM_REQY
    if (router) {
        __syncthreads();
        if (F.tid < 8) atomicAdd((unsigned*)F.ctl + CW_CNT + (l >> 1) * 16 + F.tid, (unsigned)lcnt[F.tid]);
    }
    (void)route_e;
}

__device__ __forceinline__ int carry_cr(int dir, int b, int k) {
    if (dir == 0) return k < 8 ? 1024 + b * 8 + k : b * 128 + (k - 8);
    return k < 8 ? 1024 + b * 8 + (7 - k) : b * 128 + 127 - (k - 8);
}
__device__ __forceinline__ void carry_phase(Ctx& F, int l) {
    F.tid = lt_tid(); F.lane = F.tid & 63;
    LAS float* EX = (LAS float*)F.lds;
    for (int it = F.vcu; it < 256; it += F.G) {
        const int b = it >> 5, g = it & 31;
        const int p = F.tid & 63, dir = (F.tid >> 6) & 1, seg = F.tid >> 7;
        const int pi = ((l * 2 + dir) * 32 + g) * 64 + p;
        const float are = fminf(F.in[I_ARE][pi], -1e-4f), aim = F.in[I_AIM][pi];
        const float dt = __expf(F.in[I_LOGSTEP][(l * 2 + dir) * 32 + g]);
        float s32, c32; sincos_red(aim * dt * 32.0f, s32, c32); const float m32 = __expf(are * dt * 32.0f);
        const float Lr = m32 * c32, Li = m32 * s32;
        const float* S = (const float*)(F.ws + WS_S) + (size_t)g * NCRP * 256 + dir * 128 + p;
        bf16* AY = (bf16*)(F.ws + WS_AY) + (size_t)g * NCRP * KY + 512 + dir * 128 + p;
        float sr[34], si[34];
#pragma unroll
        for (int i = 0; i < 34; ++i) { const int cr = carry_cr(dir, b, seg * 34 + i); sr[i] = S[(size_t)cr * 256]; si[i] = S[(size_t)cr * 256 + 64]; }
        float hr = 0.f, hi = 0.f, pr = 1.f, pim = 0.f;
#pragma unroll
        for (int i = 0; i < 34; ++i) { const float nr = Lr * hr - Li * hi + sr[i], ni = Lr * hi + Li * hr + si[i]; hr = nr; hi = ni; const float qr = pr * Lr - pim * Li, qi = pr * Li + pim * Lr; pr = qr; pim = qi; }
        __syncthreads();
        EX[(seg * 128 + (F.tid & 127)) * 2] = hr; EX[(seg * 128 + (F.tid & 127)) * 2 + 1] = hi;
        __syncthreads();
        float h0r = 0.f, h0i = 0.f;
        for (int j = 0; j < seg; ++j) { const float er = EX[(j * 128 + (F.tid & 127)) * 2], ei = EX[(j * 128 + (F.tid & 127)) * 2 + 1];
            const float nr = pr * h0r - pim * h0i + er, ni = pr * h0i + pim * h0r + ei; h0r = nr; h0i = ni; }
        hr = h0r; hi = h0i;
#pragma unroll
        for (int i = 0; i < 34; ++i) { const int cr = carry_cr(dir, b, seg * 34 + i);
            AY[(size_t)cr * KY] = (bf16)f2bf(hr); AY[(size_t)cr * KY + 64] = (bf16)f2bf(hi);
            const float nr = Lr * hr - Li * hi + sr[i], ni = Lr * hi + Li * hr + si[i]; hr = nr; hi = ni; }
    }
}

constexpr int SI_HP = 528, SI_AP = 272, SI_H_OFF = 0, SI_A_OFF = 144 * SI_HP, SI_EX_OFF = SI_A_OFF + 144 * SI_AP;
static_assert(SI_EX_OFF + 4 * 128 * 8 <= LDSCTL_OFF, "ssm item LDS map");
__device__ __forceinline__ int si_cr(int b, int r) { return r < 8 ? 1024 + 8 * b + r : 128 * b + r - 8; }
__device__ __forceinline__ void ssm_item(Ctx& F, int l, int b, int g, bool last) {
    F.tid = lt_tid(); F.lane = F.tid & 63;
    const int tid = F.tid, w = lt_s(F.wave), lane = F.lane, fr = lane & 15, fq = lane >> 4;
    LAS unsigned char* Hb = F.lds + SI_H_OFF; LAS unsigned char* Ab = F.lds + SI_A_OFF; LAS float* EX = (LAS float*)(F.lds + SI_EX_OFF);
    const bf16* AY = (const bf16*)(F.ws + WS_AY) + (size_t)g * NCRP * KY;
    const bf16* BtS = (const bf16*)(F.ws + WS_BTS) + (size_t)g * 256 * 512;
    const bf16* BtY = (const bf16*)(F.ws + WS_BTY) + (size_t)g * 512 * KY;
    __syncthreads();
    for (int i = tid; i < 8 * SI_AP / 4; i += 512) ((LAS unsigned*)(Ab + 136 * SI_AP))[i] = 0u;
#define SI_PREF(kc) do { _Pragma("unroll") for (int ps = 0; ps < 5; ++ps) { const int row = ps * 32 + (tid >> 4); if (row < 136) \
        pre[ps] = *(const v4u*)(AY + (size_t)si_cr(b, row) * KY + (kc) * 128 + (tid & 15) * 8); } } while (0)
#define SI_COMMIT() do { _Pragma("unroll") for (int ps = 0; ps < 5; ++ps) { const int row = ps * 32 + (tid >> 4); if (row < 136) \
        *(LAS v4u*)(Ab + row * SI_AP + (tid & 15) * 16) = pre[ps]; } } while (0)
#define SI_STAGE(kc) do { _Pragma("unroll") for (int ps = 0; ps < 5; ++ps) { const int row = ps * 32 + (tid >> 4); if (row < 136) \
        *(LAS v4u*)(Ab + row * SI_AP + (tid & 15) * 16) = *(const v4u*)(AY + (size_t)si_cr(b, row) * KY + (kc) * 128 + (tid & 15) * 8); } } while (0)
    v4u pre[5];
#pragma unroll
    for (int ps = 0; ps < 5; ++ps) pre[ps] = (v4u){0u, 0u, 0u, 0u};
    {
        f32x4 acc[2][9];
#pragma unroll
        for (int t = 0; t < 2; ++t)
#pragma unroll
            for (int mt = 0; mt < 9; ++mt) acc[t][mt] = (f32x4){0.f, 0.f, 0.f, 0.f};
        const bf16* bp = BtS + (size_t)(32 * w + fr) * 512 + 8 * fq;
        bf16x8 bw[2][4][2];
#pragma unroll
        for (int k4 = 0; k4 < 4; ++k4)
#pragma unroll
            for (int t = 0; t < 2; ++t) bw[0][k4][t] = *(const bf16x8*)(bp + (size_t)(16 * t) * 512 + 32 * k4);
        SI_PREF(0);
#pragma unroll
        for (int kc = 0; kc < 4; ++kc) {
            SI_COMMIT();
            __syncthreads();
            if (kc + 1 < 4) SI_PREF(kc + 1); else SI_PREF(0);
            if (kc + 1 < 4) {
#pragma unroll
                for (int k4 = 0; k4 < 4; ++k4)
#pragma unroll
                    for (int t = 0; t < 2; ++t) bw[(kc + 1) & 1][k4][t] = *(const bf16x8*)(bp + (size_t)(16 * t) * 512 + 32 * (4 * (kc + 1) + k4));
            }
            __builtin_amdgcn_s_setprio(1);
#pragma unroll
            for (int k4 = 0; k4 < 4; ++k4) {
#pragma unroll
                for (int mt = 0; mt < 9; ++mt) { const bf16x8 af = *(const LAS bf16x8*)(Ab + (16 * mt + fr) * SI_AP + (32 * k4 + 8 * fq) * 2);
#pragma unroll
                    for (int t = 0; t < 2; ++t) acc[t][mt] = __builtin_amdgcn_mfma_f32_16x16x32_bf16(bw[kc & 1][k4][t], af, acc[t][mt], 0, 0, 0); }
            }
            __builtin_amdgcn_s_setprio(0);
            __syncthreads();
        }
#pragma unroll
        for (int t = 0; t < 2; ++t)
#pragma unroll
            for (int mt = 0; mt < 9; ++mt) { v2u o; o.x = cvt_pk_bf16(acc[t][mt][0], acc[t][mt][1]); o.y = cvt_pk_bf16(acc[t][mt][2], acc[t][mt][3]);
                *(LAS v2u*)(Hb + (16 * mt + fr) * SI_HP + (32 * w + 16 * t + 4 * fq) * 2) = o; }
    }
    __syncthreads();
    {
        const int p = tid & 63, dir = (tid >> 6) & 1, seg = tid >> 7;
        const int pi = ((l * 2 + dir) * 32 + g) * 64 + p;
        const float are = fminf(F.in[I_ARE][pi], -1e-4f), aim = F.in[I_AIM][pi];
        const float dt = __expf(F.in[I_LOGSTEP][(l * 2 + dir) * 32 + g]);
        float s32, c32; sincos_red(aim * dt * 32.0f, s32, c32); const float m32 = __expf(are * dt * 32.0f);
        const float Lr = m32 * c32, Li = m32 * s32;
        LAS unsigned short* col = (LAS unsigned short*)(Hb + (dir * 128 + p) * 2);
        float sr[34], si[34];
#pragma unroll
        for (int i = 0; i < 34; ++i) { const int k = seg * 34 + i; const int r = dir ? (k < 8 ? 7 - k : 143 - k) : k;
            sr[i] = bf2f(col[r * (SI_HP / 2)]); si[i] = bf2f(col[r * (SI_HP / 2) + 64]); }
        float hr = 0.f, hi = 0.f, pr = 1.f, pim = 0.f;
#pragma unroll
        for (int i = 0; i < 34; ++i) { const float nr = Lr * hr - Li * hi + sr[i], ni = Lr * hi + Li * hr + si[i]; hr = nr; hi = ni; const float qr = pr * Lr - pim * Li, qi = pr * Li + pim * Lr; pr = qr; pim = qi; }
        EX[(seg * 128 + (tid & 127)) * 2] = hr; EX[(seg * 128 + (tid & 127)) * 2 + 1] = hi;
        __syncthreads();
        float h0r = 0.f, h0i = 0.f;
        for (int j = 0; j < seg; ++j) { const float er = EX[(j * 128 + (tid & 127)) * 2], ei = EX[(j * 128 + (tid & 127)) * 2 + 1];
            const float nr = pr * h0r - pim * h0i + er, ni = pr * h0i + pim * h0r + ei; h0r = nr; h0i = ni; }
        hr = h0r; hi = h0i;
#pragma unroll
        for (int i = 0; i < 34; ++i) { const int k = seg * 34 + i; const int r = dir ? (k < 8 ? 7 - k : 143 - k) : k;
            col[r * (SI_HP / 2)] = (unsigned short)f2bf(hr); col[r * (SI_HP / 2) + 64] = (unsigned short)f2bf(hi);
            const float nr = Lr * hr - Li * hi + sr[i], ni = Lr * hi + Li * hr + si[i]; hr = nr; hi = ni; }
    }
    __syncthreads();
    for (int hp = 0; hp < 2; ++hp) {
        f32x4 acc[2][9];
#pragma unroll
        for (int t = 0; t < 2; ++t)
#pragma unroll
            for (int mt = 0; mt < 9; ++mt) acc[t][mt] = (f32x4){0.f, 0.f, 0.f, 0.f};
        const bf16* bp = BtY + (size_t)(64 * w + 32 * hp + fr) * KY + 8 * fq;
        bf16x8 bw[2][4][2];
#pragma unroll
        for (int k4 = 0; k4 < 4; ++k4)
#pragma unroll
            for (int t = 0; t < 2; ++t) bw[0][k4][t] = *(const bf16x8*)(bp + (size_t)(16 * t) * KY + 32 * k4);
#pragma unroll
        for (int kc = 0; kc < 6; ++kc) {
            if (kc < 4) { SI_COMMIT(); __syncthreads(); if (kc + 1 < 4) SI_PREF(kc + 1); }
            if (kc == 4 && hp == 0) SI_PREF(0);
            if (kc + 1 < 6) {
#pragma unroll
                for (int k4 = 0; k4 < 4; ++k4)
#pragma unroll
                    for (int t = 0; t < 2; ++t) bw[(kc + 1) & 1][k4][t] = *(const bf16x8*)(bp + (size_t)(16 * t) * KY + 32 * (4 * (kc + 1) + k4));
            }
            const LAS unsigned char* abase = kc < 4 ? (const LAS unsigned char*)Ab : (const LAS unsigned char*)(Hb + (kc - 4) * 256);
            const int apitch = kc < 4 ? SI_AP : SI_HP;
            __builtin_amdgcn_s_setprio(1);
#pragma unroll
            for (int k4 = 0; k4 < 4; ++k4) {
#pragma unroll
                for (int mt = 0; mt < 9; ++mt) { const bf16x8 af = *(const LAS bf16x8*)(abase + (16 * mt + fr) * apitch + (32 * k4 + 8 * fq) * 2);
#pragma unroll
                    for (int t = 0; t < 2; ++t) acc[t][mt] = __builtin_amdgcn_mfma_f32_16x16x32_bf16(bw[kc & 1][k4][t], af, acc[t][mt], 0, 0, 0); }
            }
            __builtin_amdgcn_s_setprio(0);
            if (kc < 4) __syncthreads();
        }
        bf16* G = (bf16*)(F.ws + WS_G);
#pragma unroll
        for (int mt = 0; mt < 9; ++mt) { const int r = 16 * mt + fr;
            if (r < 136 && !(last && r < 8)) {
                const size_t tok0 = (size_t)si_cr(b, r) * 32;
#pragma unroll
                for (int t = 0; t < 2; ++t) { v2u o; o.x = cvt_pk_bf16(gelu_tanh(acc[t][mt][0]), gelu_tanh(acc[t][mt][1])); o.y = cvt_pk_bf16(gelu_tanh(acc[t][mt][2]), gelu_tanh(acc[t][mt][3]));
                    *(v2u*)(G + (tok0 + 4 * w + 2 * hp + t) * 512 + g * 16 + 4 * fq) = o; }
            }
        }
    }
#undef SI_STAGE
#undef SI_PREF
#undef SI_COMMIT
    __syncthreads();
}

constexpr int KS_STRIDE = 144, VT_STRIDE = 144, KS_SLOT = 64 * KS_STRIDE, VT_SLOT = 64 * VT_STRIDE;
typedef short v4i16_t __attribute__((ext_vector_type(4)));
template <int NKB, bool LAT>
__device__ __forceinline__ void attn_tile(const LAS unsigned char* Ks, const LAS unsigned char* Vt, int kbase, const bf16x8 (&qf)[2], f32x4 (&O)[4], float& mrun, float& lrun,
                                          int fr, int fq, const LAS float* biasrow, int qc, int cs) {
    f32x4 st[2 * NKB];
#pragma unroll
    for (int kt = 0; kt < 2 * NKB; ++kt) {
        st[kt] = (f32x4){0.f, 0.f, 0.f, 0.f};
#pragma unroll
        for (int ks = 0; ks < 2; ++ks) { const bf16x8 kf = *(const LAS bf16x8*)(Ks + (kbase + 16 * kt + fr) * KS_STRIDE + (8 * fq + 32 * ks) * 2);
            st[kt] = __builtin_amdgcn_mfma_f32_16x16x32_bf16(kf, qf[ks], st[kt], 0, 0, 0); }
    }
    float tmax = -3.0e38f;
#pragma unroll
    for (int kt = 0; kt < 2 * NKB; ++kt)
#pragma unroll
        for (int i = 0; i < 4; ++i) {
            if (LAT) { const int kc = kbase + 16 * kt + 4 * fq + i; const bool ok = (kc >= cs) && (kc < cs + 16);
                const float bv = biasrow[ok ? (kc - qc + 15) : 0];
                st[kt][i] = ok ? st[kt][i] + bv : -__builtin_inff(); }
            tmax = fmaxf(tmax, st[kt][i]);
        }
    tmax = fmaxf(tmax, __shfl_xor(tmax, 16)); tmax = fmaxf(tmax, __shfl_xor(tmax, 32));
    const float mnew = fmaxf(mrun, tmax), alpha = __builtin_amdgcn_exp2f(mrun - mnew);
    float ps = 0.f;
#pragma unroll
    for (int kt = 0; kt < 2 * NKB; ++kt)
#pragma unroll
        for (int i = 0; i < 4; ++i) { const float pv = __builtin_amdgcn_exp2f(st[kt][i] - mnew); st[kt][i] = pv; ps += pv; }
    lrun = lrun * alpha + ps; mrun = mnew;
#pragma unroll
    for (int dt = 0; dt < 4; ++dt) O[dt] = O[dt] * alpha;
#pragma unroll
    for (int kb = 0; kb < NKB; ++kb) {
        union { bf16x8 v; unsigned u[4]; } pf;
        pf.u[0] = cvt_pk_bf16(st[2 * kb][0], st[2 * kb][1]); pf.u[1] = cvt_pk_bf16(st[2 * kb][2], st[2 * kb][3]);
        pf.u[2] = cvt_pk_bf16(st[2 * kb + 1][0], st[2 * kb + 1][1]); pf.u[3] = cvt_pk_bf16(st[2 * kb + 1][2], st[2 * kb + 1][3]);
#pragma unroll
        for (int dt = 0; dt < 4; ++dt) {
            union { bf16x8 v; v4i16_t t[2]; } vf;
            const LAS unsigned char* vp = Vt + (kbase + 32 * kb + 4 * fq + (fr >> 2)) * VT_STRIDE + (16 * dt + 4 * (fr & 3)) * 2;
            vf.t[0] = __builtin_amdgcn_ds_read_tr16_b64_v4i16((LAS v4i16_t*)vp); vf.t[1] = __builtin_amdgcn_ds_read_tr16_b64_v4i16((LAS v4i16_t*)(vp + 16 * VT_STRIDE));
            O[dt] = __builtin_amdgcn_mfma_f32_16x16x32_bf16(vf.v, pf.v, O[dt], 0, 0, 0);
        }
    }
}
__device__ __forceinline__ float xl_max4(float x) {
    unsigned u = __builtin_bit_cast(unsigned, x); auto a = __builtin_amdgcn_permlane16_swap(u, u, false, false);
    const float m = fmaxf(__builtin_bit_cast(float, a[0]), __builtin_bit_cast(float, a[1]));
    u = __builtin_bit_cast(unsigned, m); auto b = __builtin_amdgcn_permlane32_swap(u, u, false, false);
    return fmaxf(__builtin_bit_cast(float, b[0]), __builtin_bit_cast(float, b[1]));
}
template <bool LAT, int NQ, int TN>
__device__ __forceinline__ void attn_stage(const LAS unsigned char* stg, int cnt, int tile_b, const bf16x8 (&qf)[NQ][2], f32x4 (&O)[NQ][4], float (&mrun)[NQ], float (&lrun)[NQ],
                                           int fr, int fq, int kbase, const LAS float* bias_s, int kr0, const int (&my_rs)[NQ], const int (&qrow)[NQ], int qc, int cs) {
    constexpr int NKT = LAT ? 2 : 4, NKB = NKT / 2;
    f32x4 st[NQ][TN][NKT];
    bool rvq[NQ][TN];
#pragma unroll
    for (int q = 0; q < NQ; ++q)
#pragma unroll
        for (int j = 0; j < TN; ++j) rvq[q][j] = LAT ? (j < cnt && (kr0 + j) >= my_rs[q] && (kr0 + j) < my_rs[q] + 8) : true;
#pragma unroll
    for (int j = 0; j < TN; ++j) {
        bool rva = false;
#pragma unroll
        for (int q = 0; q < NQ; ++q) rva = rva || rvq[q][j];
#pragma unroll
        for (int q = 0; q < NQ; ++q)
#pragma unroll
            for (int kt = 0; kt < NKT; ++kt) st[q][j][kt] = (f32x4){0.f, 0.f, 0.f, 0.f};
        if (rva) {
            const LAS unsigned char* Ks = stg + j * tile_b;
            __builtin_amdgcn_s_setprio(1);
#pragma unroll
            for (int kt = 0; kt < NKT; ++kt)
#pragma unroll
                for (int ks = 0; ks < 2; ++ks) { const bf16x8 kf = *(const LAS bf16x8*)(Ks + (kbase + 16 * kt + fr) * KS_STRIDE + (8 * fq + 32 * ks) * 2);
#pragma unroll
                    for (int q = 0; q < NQ; ++q) if (rvq[q][j]) st[q][j][kt] = __builtin_amdgcn_mfma_f32_16x16x32_bf16(kf, qf[q][ks], st[q][j][kt], 0, 0, 0); }
            __builtin_amdgcn_s_setprio(0);
        }
        if (NQ > 1) __builtin_amdgcn_sched_barrier(0);
    }
#pragma unroll
    for (int q = 0; q < NQ; ++q) {
        float tmax = -3.0e38f;
#pragma unroll
        for (int j = 0; j < TN; ++j) {
            if (rvq[q][j]) {
                if (LAT) { const int rrel = min(max(kr0 + j - qrow[q] + 7, 0), 14);
#pragma unroll
                    for (int kt = 0; kt < NKT; ++kt)
#pragma unroll
                        for (int i = 0; i < 4; ++i) { const int kc = kbase + 16 * kt + 4 * fq + i; const bool ok = (kc >= cs) && (kc < cs + 16);
                            const float bv = bias_s[rrel * 31 + min(max(kc - qc + 15, 0), 30)];
                            st[q][j][kt][i] = ok ? st[q][j][kt][i] + bv : -__builtin_inff(); tmax = fmaxf(tmax, st[q][j][kt][i]); }
                } else {
#pragma unroll
                    for (int kt = 0; kt < NKT; ++kt)
#pragma unroll
                        for (int i = 0; i < 4; ++i) tmax = fmaxf(tmax, st[q][j][kt][i]);
                }
            }
        }
        tmax = xl_max4(tmax);
        const float mnew = fmaxf(mrun[q], tmax), alpha = __builtin_amdgcn_exp2f(mrun[q] - mnew);
        float ps = 0.f;
#pragma unroll
        for (int j = 0; j < TN; ++j) {
            if (rvq[q][j]) {
#pragma unroll
                for (int kt = 0; kt < NKT; ++kt)
#pragma unroll
                    for (int i = 0; i < 4; ++i) { const float pv = __builtin_amdgcn_exp2f(st[q][j][kt][i] - mnew); st[q][j][kt][i] = pv; ps += pv; }
            }
        }
        lrun[q] = lrun[q] * alpha + ps; mrun[q] = mnew;
#pragma unroll
        for (int dt = 0; dt < 4; ++dt) O[q][dt] = O[q][dt] * alpha;
    }
#pragma unroll
    for (int j = 0; j < TN; ++j) {
        bool rva = false;
#pragma unroll
        for (int q = 0; q < NQ; ++q) rva = rva || rvq[q][j];
        if (rva) {
            const LAS unsigned char* Vt = stg + j * tile_b + KS_SLOT;
#pragma unroll
            for (int kb = 0; kb < NKB; ++kb) {
                union { bf16x8 v; unsigned u[4]; } pf[NQ];
#pragma unroll
                for (int q = 0; q < NQ; ++q) {
                    pf[q].u[0] = cvt_pk_bf16(st[q][j][2 * kb][0], st[q][j][2 * kb][1]); pf[q].u[1] = cvt_pk_bf16(st[q][j][2 * kb][2], st[q][j][2 * kb][3]);
                    pf[q].u[2] = cvt_pk_bf16(st[q][j][2 * kb + 1][0], st[q][j][2 * kb + 1][1]); pf[q].u[3] = cvt_pk_bf16(st[q][j][2 * kb + 1][2], st[q][j][2 * kb + 1][3]); }
                __builtin_amdgcn_s_setprio(1);
#pragma unroll
                for (int dt = 0; dt < 4; ++dt) {
                    union { bf16x8 v; v4i16_t t[2]; } vf;
                    const LAS unsigned char* vp = Vt + (kbase + 32 * kb + 4 * fq + (fr >> 2)) * VT_STRIDE + (16 * dt + 4 * (fr & 3)) * 2;
                    vf.t[0] = __builtin_amdgcn_ds_read_tr16_b64_v4i16((LAS v4i16_t*)vp); vf.t[1] = __builtin_amdgcn_ds_read_tr16_b64_v4i16((LAS v4i16_t*)(vp + 16 * VT_STRIDE));
#pragma unroll
                    for (int q = 0; q < NQ; ++q) if (rvq[q][j]) O[q][dt] = __builtin_amdgcn_mfma_f32_16x16x32_bf16(vf.v, pf[q].v, O[q][dt], 0, 0, 0);
                }
                __builtin_amdgcn_s_setprio(0);
                if (NQ > 1) __builtin_amdgcn_sched_barrier(0);
            }
        }
    }
}
constexpr int ATT_TG = 4, ATT_TILE_B = KS_SLOT + VT_SLOT, ATT_STAGE_B = ATT_TG * ATT_TILE_B, ATT_BIAS2_OFF = LDSCTL_OFF + 1024, ATT_BIAS_B = 1920;
static_assert(2 * ATT_STAGE_B <= LDSCTL_OFF && ATT_BIAS2_OFF + 2 * ATT_BIAS_B <= LDS_BYTES, "attention LDS map");
constexpr int ATT_NLAT_ITEMS = 1024;
struct AttItem { int b, h, rq, rsA, ntile, nstage; };
__device__ __forceinline__ AttItem att_dec(int it) { AttItem a; a.b = it >> 7; a.h = (it >> 4) & 7; a.rq = it & 15; a.rsA = min(max(4 * a.rq - 4, 0), 56); const int rsD = min(max(4 * a.rq - 1, 0), 56);
    a.ntile = rsD + 8 - a.rsA + 4; a.nstage = (a.ntile + ATT_TG - 1) / ATT_TG; return a; }
__device__ __forceinline__ void attn_phase(Ctx& F, int l, bool do_ctx, int it0, int nit, int stride) {
    F.tid = lt_tid(); F.lane = F.tid & 63;
    LAS unsigned char* lds = F.lds;
    const bf16* Qb = (const bf16*)(F.ws + WS_Q); const bf16* Kb = (const bf16*)(F.ws + WS_K); const bf16* Vb = (const bf16*)(F.ws + WS_V);
    bf16* YA = (bf16*)(F.ws + WS_YA);
    const int tid = F.tid, w = lt_s(F.wave), lane = F.lane, fr = lane & 15, fq = lane >> 4;
    const int lkey = tid >> 3, lch = tid & 7, ct = w & 3, qc = 16 * ct + fr;
    const int wsc = min(max(16 * ct - 8, 0), 32), cs = min(max(qc - 8, 0), 48);
    const float* rpb = F.in[I_RPB] + (size_t)l * 8 * 465;
    {
        int lit = it0, lst = 0, lpar = 0, lrem = nit; bool lvalid = lrem > 0; AttItem LI = att_dec(lvalid ? lit : 0);
        int cit = it0, cst = 0, cpar = 0, crem = nit; AttItem CI = att_dec(crem > 0 ? cit : 0);
        v4u k0r[ATT_TG], v0r[ATT_TG]; float bias0 = 0.f; int cnt0 = 0, fst0 = 0;
        bf16x8 qf[2][2]; f32x4 O[2][4]; float mrun[2] = {-1.0e30f, -1.0e30f}, lrun[2] = {0.f, 0.f}; int qrow[2] = {0, 0}, my_rs[2] = {0, 0};
#pragma unroll
        for (int q = 0; q < 2; ++q) { qf[q][0] = (bf16x8){0,0,0,0,0,0,0,0}; qf[q][1] = qf[q][0];
#pragma unroll
            for (int dt = 0; dt < 4; ++dt) O[q][dt] = (f32x4){0.f, 0.f, 0.f, 0.f}; }
#define ATT_LD(KR, VR, BIASR, CNT, FST) do { CNT = 0; FST = 0; if (lvalid) { CNT = min(ATT_TG, LI.ntile - ATT_TG * lst); FST = (lst == 0) ? (1 + lpar) : 0; \
            const size_t hoff = (size_t)LI.h * 64 + 8 * lch; \
            _Pragma("unroll") for (int j = 0; j < ATT_TG; ++j) if (j < CNT) { const int t = lst * ATT_TG + j; \
                const int tokk = (t < 4 ? MLAT + LI.b * 256 + 64 * t : LI.b * 4096 + (LI.rsA + t - 4) * 64) + lkey; \
                KR[j] = *(const v4u*)(Kb + (size_t)tokk * 512 + hoff); VR[j] = *(const v4u*)(Vb + (size_t)tokk * 512 + hoff); } \
            if (lst == 0) { BIASR = tid < 465 ? rpb[LI.h * 465 + tid] * LOG2E : 0.f; } \
            ++lst; if (lst == LI.nstage) { lit += stride; --lrem; lvalid = lrem > 0; if (lvalid) LI = att_dec(lit); lst = 0; lpar ^= 1; } } } while (0)
#define ATT_ST(KR, VR, BIASR, CNT, FST, BUF) do { \
            _Pragma("unroll") for (int j = 0; j < ATT_TG; ++j) if (j < CNT) { \
                LAS unsigned char* Ks = lds + (BUF) * ATT_STAGE_B + j * ATT_TILE_B; LAS unsigned char* Vt = Ks + KS_SLOT; \
                *(LAS v4u*)(Ks + lkey * KS_STRIDE + lch * 16) = KR[j]; *(LAS v4u*)(Vt + lkey * VT_STRIDE + lch * 16) = VR[j]; } \
            if (FST && tid < 465) ((LAS float*)(lds + ATT_BIAS2_OFF + (FST - 1) * ATT_BIAS_B))[tid] = BIASR; } while (0)
#define ATT_QLD() do { if (crem > 0) { _Pragma("unroll") for (int q = 0; q < 2; ++q) {        \
                    qrow[q] = 4 * CI.rq + 2 * (w >> 2) + q; my_rs[q] = min(max(qrow[q] - 4, 0), 56); const int tq_ = CI.b * 4096 + qrow[q] * 64 + qc; \
                    qf[q][0] = *(const bf16x8*)(Qb + (size_t)tq_ * 512 + CI.h * 64 + 8 * fq); qf[q][1] = *(const bf16x8*)(Qb + (size_t)tq_ * 512 + CI.h * 64 + 32 + 8 * fq); } } } while (0)
#define ATT_COMPUTE(BUF) do { \
            if (cst == 0) { _Pragma("unroll") for (int q = 0; q < 2; ++q) { mrun[q] = -1.0e30f; lrun[q] = 0.f; \
                    _Pragma("unroll") for (int dt = 0; dt < 4; ++dt) O[q][dt] = (f32x4){0.f, 0.f, 0.f, 0.f}; } } \
            const LAS float* bias_s = (const LAS float*)(lds + ATT_BIAS2_OFF + cpar * ATT_BIAS_B); \
            if (cst == 0) { _Pragma("unroll") for (int j_ = 0; j_ < 4; ++j_) { attn_stage<false, 2, 1>(lds + (BUF) * ATT_STAGE_B + j_ * ATT_TILE_B, 1, ATT_TILE_B, qf, O, mrun, lrun, fr, fq, 0, bias_s, 0, my_rs, qrow, 0, 0); __builtin_amdgcn_sched_barrier(0); } } \
            else { const int cn_ = min(ATT_TG, CI.ntile - ATT_TG * cst), kr_ = CI.rsA + ATT_TG * cst - 4; \
                attn_stage<true, 2, 2>(lds + (BUF) * ATT_STAGE_B, min(cn_, 2), ATT_TILE_B, qf, O, mrun, lrun, fr, fq, wsc, bias_s, kr_, my_rs, qrow, qc, cs); __builtin_amdgcn_sched_barrier(0); \
                if (cn_ > 2) attn_stage<true, 2, 2>(lds + (BUF) * ATT_STAGE_B + 2 * ATT_TILE_B, cn_ - 2, ATT_TILE_B, qf, O, mrun, lrun, fr, fq, wsc, bias_s, kr_ + 2, my_rs, qrow, qc, cs); } \
            ++cst; \
            if (cst == CI.nstage) { _Pragma("unroll") for (int q = 0; q < 2; ++q) { float ls = lrun[q]; ls += __shfl_xor(ls, 16); ls += __shfl_xor(ls, 32); const float inv = 1.0f / ls; \
                    _Pragma("unroll") for (int dt = 0; dt < 4; ++dt) { v2u o; o.x = pk2(O[q][dt][0] * inv, O[q][dt][1] * inv); o.y = pk2(O[q][dt][2] * inv, O[q][dt][3] * inv); \
                        *(v2u*)(YA + (size_t)(CI.b * 4096 + qrow[q] * 64 + qc) * 1024 + 512 + CI.h * 64 + 16 * dt + 4 * fq) = o; } } \
                cit += stride; --crem; if (crem > 0) CI = att_dec(cit); cst = 0; cpar ^= 1; ATT_QLD(); } } while (0)
        if (crem > 0) {
            __syncthreads();
            ATT_QLD();
            ATT_LD(k0r, v0r, bias0, cnt0, fst0);
            ATT_ST(k0r, v0r, bias0, cnt0, fst0, 0);
            __syncthreads();
            for (;;) {
                ATT_LD(k0r, v0r, bias0, cnt0, fst0);
                ATT_COMPUTE(0);
                if (crem <= 0) break;
                ATT_ST(k0r, v0r, bias0, cnt0, fst0, 1);
                __syncthreads();
                ATT_LD(k0r, v0r, bias0, cnt0, fst0);
                ATT_COMPUTE(1);
                if (crem <= 0) break;
                ATT_ST(k0r, v0r, bias0, cnt0, fst0, 0);
                __syncthreads();
            }
        }
#undef ATT_LD
#undef ATT_ST
#undef ATT_COMPUTE
#undef ATT_QLD
    }
    if (do_ctx) {
        for (int it = F.vcu; it < 128; it += F.G) {
            const int b = it >> 4, h = (it >> 1) & 7, half = it & 1;
            const int tokq = MLAT + b * 256 + half * 128 + w * 16 + fr;
            const size_t hoff = (size_t)h * 64 + 8 * lch;
            v4u kreg[4], vreg[4];
#pragma unroll
            for (int j = 0; j < 4; ++j) { const int tokk = MLAT + b * 256 + 64 * j + lkey; kreg[j] = *(const v4u*)(Kb + (size_t)tokk * 512 + hoff); vreg[j] = *(const v4u*)(Vb + (size_t)tokk * 512 + hoff); }
            bf16x8 qf[1][2];
            qf[0][0] = *(const bf16x8*)(Qb + (size_t)tokq * 512 + h * 64 + 8 * fq); qf[0][1] = *(const bf16x8*)(Qb + (size_t)tokq * 512 + h * 64 + 32 + 8 * fq);
            __syncthreads();
#pragma unroll
            for (int j = 0; j < 4; ++j) { LAS unsigned char* Ks = lds + j * ATT_TILE_B; LAS unsigned char* Vt = Ks + KS_SLOT;
                *(LAS v4u*)(Ks + lkey * KS_STRIDE + lch * 16) = kreg[j]; *(LAS v4u*)(Vt + lkey * VT_STRIDE + lch * 16) = vreg[j]; }
            __syncthreads();
            f32x4 O[1][4];
#pragma unroll
            for (int dt = 0; dt < 4; ++dt) O[0][dt] = (f32x4){0.f, 0.f, 0.f, 0.f};
            float mrun[1] = {-1.0e30f}, lrun[1] = {0.f}; const int zz[1] = {0};
            attn_stage<false, 1, 4>(lds, 4, ATT_TILE_B, qf, O, mrun, lrun, fr, fq, 0, (const LAS float*)lds, 0, zz, zz, 0, 0);
            float ls = lrun[0]; ls += __shfl_xor(ls, 16); ls += __shfl_xor(ls, 32);
            const float inv = 1.0f / ls;
#pragma unroll
            for (int dt = 0; dt < 4; ++dt) { v2u o; o.x = pk2(O[0][dt][0] * inv, O[0][dt][1] * inv); o.y = pk2(O[0][dt][2] * inv, O[0][dt][3] * inv);
                *(v2u*)(YA + (size_t)tokq * 1024 + 512 + h * 64 + 16 * dt + 4 * fq) = o; }
        }
    }
}

__device__ __forceinline__ void scatter_phase(Ctx& F, int l, int M, int ncopy) {
    F.tid = lt_tid(); F.lane = F.tid & 63;
    LAS int* lc = (LAS int*)F.lds;
    LAS int* gb = lc + 8; LAS int* lpos = lc + 16;
    const unsigned* cnt = (const unsigned*)F.ctl + CW_CNT + (l >> 1) * 16;
    const int* route_e = (const int*)(F.ws + WS_ROUTE); int* slot_of = (int*)(F.ws + WS_ROUTE + 576 * 1024);
    int* src_of = (int*)(F.ws + WS_ROUTE + 1024 * 1024);
    int segp[9]; moe_seg(cnt, segp);
    const int per = M / F.G;
    const int t0 = F.vcu * per;
    LAS int* ent = lc + 16 + 512;
    if (F.tid < 8) gb[F.tid] = 0;
    __syncthreads();
    const int nent = 2 * per;
    int my_e = 0;
    if (F.tid < nent) { const int tok = t0 + (F.tid >> 1), re = route_e[tok]; my_e = (F.tid & 1) ? (re >> 8) : (re & 255); ent[F.tid] = my_e; }
    if (F.tid < F.vcu && F.tid < 256) { const unsigned* bc = (const unsigned*)F.ctl + CW_BCNT + ((l >> 1) * 256 + F.tid) * 8;
#pragma unroll
        for (int e = 0; e < 8; ++e) { const int c = (int)bc[e]; if (c) __hip_atomic_fetch_add(&gb[e], c, __ATOMIC_RELAXED, __HIP_MEMORY_SCOPE_WORKGROUP); } }
    __syncthreads();
    if (F.tid < nent) { int rank = 0; for (int j = 0; j < F.tid; ++j) rank += (ent[j] == my_e) ? 1 : 0;
        const int slot = segp[my_e] * 256 + gb[my_e] + rank; slot_of[2 * t0 + F.tid] = slot; src_of[slot] = t0 + (F.tid >> 1); }
    (void)ncopy; (void)lpos;
}

constexpr int NPL = 14;
constexpr int NPHASE = 1 + DEPTH * NPL + 1;
__global__ void __launch_bounds__(512, 2) mk_fwd(Args args) {
    extern __shared__ __attribute__((aligned(16))) unsigned char lds_raw[];
    Ctx F;
    F.lds = (LAS unsigned char*)lds_raw; F.ws = args.ws; F.ctl = (gu32*)(args.ws + WS_CTL);
    F.tid = threadIdx.x; F.lane = F.tid & 63; F.wave = __builtin_amdgcn_readfirstlane(F.tid >> 6);
    F.G = 256; { const int bx = blockIdx.x; F.vcu = (bx % 8) * 32 + bx / 8; }
    F.in = (const float* const __attribute__((address_space(4)))*)__builtin_amdgcn_kernarg_segment_ptr(); F.out = args.out;
    volatile LAS unsigned* MISC = (volatile LAS unsigned*)(F.lds + MISC_OFF);
    for (int u = F.tid; u < (LDS_BYTES - LDSCTL_OFF) / 4; u += 512) ((LAS unsigned*)(F.lds + LDSCTL_OFF))[u] = 0u;
    __syncthreads();
    XcdBarrier bar; bar.bar = (unsigned*)(F.ctl + CW_BAR); bar.x = 0; bar.st = nullptr;
    if (MK_ONE_LAUNCH) bar = xcd_barrier_post((unsigned*)(F.ctl + CW_BAR), MISC + 8);
    const int lo = args.ph_lo, hi = args.ph_hi;
#ifndef MK_PHASES
#define MK_PHASES 0xFFFFFFFFu
#endif
#define PHEN(j) (((MK_PHASES) >> (j)) & 1u)
#define IN(k) (lo <= (k) && (k) < hi)
#ifndef MK_DUP
#define MK_DUP 0u
#endif
#ifndef MK_DUPN
#define MK_DUPN 2
#endif
#define REPS(j) ((((MK_DUP) >> (j)) & 1u) ? MK_DUPN : 1)
#define REPLOOP(j) for (int rep = 0; rep < REPS(j); ++rep)
#define REPBAR() do { if (rep) xcd_barrier(bar); } while (0)
    const float* const gate_zero = (const float*)(F.ctl + 65536);
#define SEAM_BODY() do { if (MK_CONV_SEAM && cv_target < DEPTH) { const XbTok tk_ = xcd_arrive(bar); \
        volatile LAS int* bc_ = (volatile LAS int*)(F.lds + LDSCTL_OFF + 512); \
        if (lt_tid() == 0) bc_[0] = (tk_.role == 0) ? (int)__hip_atomic_fetch_add(F.ctl + CW_Q + 64 * (cv_target * 8 + (int)(bar.x & 7u)), 1u, RLX_AGENT) : 0x7fffff;     \
        __syncthreads(); \
        { const int t_ = (bc_[0] * 8 + (int)(bar.x & 7u)) * 8 + F.wave; if (t_ < conv_ntiles(cv_target)) conv_tile(F, cv_target, t_, (LAS float*)(F.lds + F.wave * 16640), lt_tid() & 63); } \
        xcd_wait(bar, tk_); } else xcd_barrier(bar); } while (0)
#define SEAM(k) do { if (IN(k) && IN((k) + 1)) SEAM_BODY(); } while (0)
    int cv_target = DEPTH, cv_next = 0, cv_prev_done = 0;
    bf16* const HB = (bf16*)(F.ws + WS_HB); bf16* const X = (bf16*)(F.ws + WS_X);
    const float* const mod = (const float*)(F.ws + WS_MOD);

#ifdef MK_XBAR
    if (MK_ONE_LAUNCH) for (int xb = 0; xb < MK_XBAR; ++xb) xcd_barrier(bar);
#endif
    if (IN(0) && PHEN(20)) REPLOOP(20) { REPBAR(); mod_phase(F); }
    SEAM(0);
    for (int l = 0; l < DEPTH; ++l) {
        const int pb = 1 + l * NPL;
        const bool last = (l == DEPTH - 1), moe = (l & 1) != 0;
        cv_target = (MK_ONE_LAUNCH && l + 1 < DEPTH && ((l + 1) & 1)) ? l + 1 : DEPTH; cv_next = 0;
        if (IN(pb + 0) && PHEN(0)) {
            for (int rep = 0; rep < REPS(14); ++rep) { ssm_prepA(F, l, F.vcu >> 3, F.vcu & 7); }
            __syncthreads();
            if (MK_CONV_SEAM && MK_ONE_LAUNCH && (l & 1)) wconv_drain(F, l, bar.x); else
            for (int rep = 0; rep < REPS(15); ++rep) wconv_phase(F, l, 0);
            for (int rep = 0; rep < REPS(16); ++rep) norm_phase<0>(F, l, MTOT, l == 0 && rep == 0, l > 0 && ((l - 1) & 1) && rep == 0, false, ((l & 1) && rep == 0 && MK_SPLIT_FFN2 > 1) ? mod + ((size_t)(l - 1) * 9 + 8) * 6144 + 5 * 1024 : nullptr, MK_SPLIT_FFN2);
        }
        SEAM(pb + 0);
        if (IN(pb + 1) && PHEN(1)) REPLOOP(1) { REPBAR();
            pg8::Gemm g{HB, (const bf16*)(F.ws + ws_win(l)), 1024, 1024, 1024};
            pg8::TileOrder S; S.init(MTOT / 256, INW / 256, F.G, (int)blockIdx.x, (size_t)256 * 1024 * 2, (size_t)256 * 1024 * 2, 0); S.wgm = MK_WGM_INP;
            EpiInProj E{(bf16*)(F.ws + WS_AY), (bf16*)(F.ws + WS_Q), (bf16*)(F.ws + WS_K), (bf16*)(F.ws + WS_V)};
            pg8::gemm_phase(F.lds, g, S, E);
            if (MK_SSM_FUSED && rep == 0 && !MK_DIAG_PREPB) { ssm_prepB(F, l, F.vcu >> 3, F.vcu & 7); }
        }
        SEAM(pb + 1);
#if MK_SSM_FUSED
        if (IN(pb + 2) && (PHEN(2) || PHEN(5))) {
            if (MK_DIAG_PREPB) { for (int it = F.vcu; it < NG * 8; it += F.G) ssm_prepB(F, l, it >> 3, it & 7); xcd_barrier(bar); }
            if (PHEN(5)) for (int rep = 0; rep < REPS(5); ++rep) { if (rep) xcd_barrier(bar); __syncthreads(); attn_phase(F, l, !last, F.vcu, (ATT_NLAT_ITEMS - F.vcu + F.G - 1) / F.G, F.G); }
            if (PHEN(2)) for (int rep = 0; rep < REPS(2); ++rep) { if (rep) xcd_barrier(bar); ssm_item(F, l, F.vcu >> 5, F.vcu & 31, last); }
        }
        SEAM(pb + 2);
#else
        if (IN(pb + 2) && PHEN(2)) REPLOOP(2) { REPBAR();
            pg8::Gemm g{(const bf16*)(F.ws + WS_AY), (const bf16*)(F.ws + WS_BTS), 512, KY, 512};
            pg8::TileOrder S; S.init(NG * 5, 1, F.G, (int)blockIdx.x, (size_t)256 * KY * 2, (size_t)256 * 512 * 2, 5); S.wgm = MK_WGM_SSM;
            EpiS E{(float*)(F.ws + WS_S)};
            pg8::gemm_phase(F.lds, g, S, E);
            if (MK_ATT_SPREAD && rep == 0 && (int)blockIdx.x >= 160) { __syncthreads(); attn_phase(F, l, false, (int)blockIdx.x - 160, 1, 1); }
        }
        SEAM(pb + 2);
        if (IN(pb + 3) && PHEN(3)) REPLOOP(3) { REPBAR(); carry_phase(F, l); for (int it = F.vcu; it < NG * 8; it += F.G) ssm_prepB(F, l, it >> 3, it & 7); }
        if (IN(pb + 3) && PHEN(5)) REPLOOP(5) { if (rep) xcd_barrier(bar); __syncthreads();
            const int a0 = MK_ATT_SPREAD ? 480 + F.vcu : F.vcu; attn_phase(F, l, !last, a0, (2048 - a0 + F.G - 1) / F.G, F.G); }
        SEAM(pb + 3);
        if (IN(pb + 4) && PHEN(4)) REPLOOP(4) { REPBAR();
            pg8::Gemm g{(const bf16*)(F.ws + WS_AY), (const bf16*)(F.ws + WS_BTY), KY, KY, KY};
            pg8::TileOrder S; S.init(NG * 5, 2, F.G, (int)blockIdx.x, (size_t)256 * KY * 2, (size_t)256 * KY * 2, 5);
            if (last) { S.init(NG * 4, 2, F.G, (int)blockIdx.x, (size_t)256 * KY * 2, (size_t)256 * KY * 2, 5); S.skip5 = 1; }
            S.wgm = MK_WGM_SSM;
            EpiY E{(bf16*)(F.ws + WS_G)};
            pg8::gemm_phase(F.lds, g, S, E);
            if (MK_ATT_SPREAD && rep == 0 && (int)blockIdx.x >= 64) { __syncthreads(); attn_phase(F, l, false, 96 + ((int)blockIdx.x - 64) * 2, 2, 1); }
        }
        SEAM(pb + 4);
#endif
        if (IN(pb + 6) && PHEN(6)) REPLOOP(6) { REPBAR();
            pg8::Gemm g{(const bf16*)(F.ws + WS_G), (const bf16*)(F.ws + ws_wglu(l)), 512, 512, 512};
            pg8::TileOrder S; S.init((last ? MLAT : MTOT) / 256, 2, F.G, (int)blockIdx.x, (size_t)256 * 512 * 2, (size_t)256 * 512 * 2, 0);
            S.wgm = MK_WGM_GLU;
            EpiGlu E{(const bf16*)(F.ws + WS_G), F.in[I_GLUB] + l * 512, (bf16*)(F.ws + WS_YA)};
            pg8::gemm_phase(F.lds, g, S, E);
        }
        SEAM(pb + 6);
        if (IN(pb + 7) && PHEN(7)) REPLOOP(7) { REPBAR();
            pg8::Gemm g{(const bf16*)(F.ws + WS_YA), (const bf16*)(F.ws + ws_wout(l)), 1024, 1024, 1024};
            pg8::TileOrder S; S.init((last ? MLAT : MTOT) / 256, 4, F.G, (int)blockIdx.x, (size_t)256 * 1024 * 2, (size_t)256 * 1024 * 2, 0); if (!last && MK_SPLIT_OUT > 1) { S.init(MLAT / 256, 4, F.G, (int)blockIdx.x, (size_t)256 * 1024 * 2, (size_t)256 * 1024 * 2, 0); S.ntk = 16; S.nsplit = MK_SPLIT_OUT; S.xpm0 = MLAT / 256; S.xnp = MCTX / 256; }
            S.wgm = MK_WGM_OUT;
#ifdef MK_NULLEPI3
            if (rep) { EpiNull E{(float*)(F.ws + WS_G)}; pg8::gemm_phase(F.lds, g, S, E); } else
#endif
            { EpiRes E{X, rep ? gate_zero : mod + (size_t)l * 9 * 6144 + 2 * 1024, (float*)(F.ws + WS_SLAB)};
            pg8::gemm_phase(F.lds, g, S, E); }
        }
        SEAM(pb + 7);
        const int MF = last ? MLAT : MTOT;
        if (IN(pb + 8) && PHEN(8)) REPLOOP(8) { REPBAR(); norm_phase<1>(F, l, MF, false, false, moe && rep == 0, (!last && rep == 0 && MK_SPLIT_OUT > 1) ? mod + ((size_t)l * 9 + 8) * 6144 + 2 * 1024 : nullptr, MK_SPLIT_OUT); }
        SEAM(pb + 8);
        if (!moe) {
            if (IN(pb + 9) && PHEN(9)) REPLOOP(9) { REPBAR();
                pg8::Gemm g{HB, (const bf16*)(F.ws + WS_DW13), 1024, 1024, 1024};
                pg8::TileOrder S; S.init(MF / 256, 22, F.G, (int)blockIdx.x, (size_t)256 * 1024 * 2, (size_t)256 * 1024 * 2, 0);
                EpiSwiGlu E{(bf16*)(F.ws + WS_ACT), ACT_LD, 0, MK_BLOCKED_ACT};
                pg8::gemm_phase(F.lds, g, S, E);
            }
            SEAM(pb + 9);
            if (IN(pb + 10) && PHEN(10)) REPLOOP(10) { REPBAR();
                pg8::Gemm g{(const bf16*)(F.ws + WS_ACT), (const bf16*)(F.ws + WS_DW2), DFF, MK_BLOCKED_ACT ? 64 : ACT_LD, DW2_LD, MK_BLOCKED_ACT ? 256 * 128 : 128};
                pg8::TileOrder S; S.init(MF / 256, 4, F.G, (int)blockIdx.x, (size_t)256 * ACT_LD * 2, (size_t)256 * DW2_LD * 2, 0); if (!last && MK_SPLIT_FFN2 > 1) { S.init(MLAT / 256, 4, F.G, (int)blockIdx.x, (size_t)256 * ACT_LD * 2, (size_t)256 * DW2_LD * 2, 0); S.ntk = 44; S.nsplit = MK_SPLIT_FFN2; S.xpm0 = MLAT / 256; S.xnp = MCTX / 256; }
                if (MK_BLOCKED_ACT) S.kpA = 2 * 256 * 128;
                S.wgm = MK_WGM_F2;
#ifdef MK_NULLEPI2
                if (rep) { EpiNull E{(float*)(F.ws + WS_YA)}; pg8::gemm_phase(F.lds, g, S, E); } else
#endif
                { EpiRes E{X, rep ? gate_zero : mod + (size_t)l * 9 * 6144 + 5 * 1024, (float*)(F.ws + WS_SLAB)};
                pg8::gemm_phase(F.lds, g, S, E); }
            }
            if (IN(pb + 10) && IN(pb + NPL)) SEAM_BODY();
        } else {
            if (IN(pb + 9) && PHEN(11)) { scatter_phase(F, l, MF, 1); }
            SEAM(pb + 9);
            const unsigned* cnt = (const unsigned*)F.ctl + CW_CNT + (l >> 1) * 16;
            {
                int segp[9]; moe_seg(cnt, segp);
                const int P = segp[8];
                if (IN(pb + 10) && PHEN(12)) REPLOOP(12) { REPBAR();
                    pg8::Gemm g{(const bf16*)(F.ws + WS_XS), (const bf16*)(F.ws + WS_W13), 1024, 1024, 1024};
                    pg8::MoeOrder S; S.nM = P; S.nN = 28; S.nwg = P * 28; S.G = F.G; S.c = (int)blockIdx.x; S.p0 = 0; S.sA = (size_t)256 * 1024 * 2; S.sB = (size_t)256 * 1024 * 2; S.a_local = 0; S.wgm = MK_WGM_M1;
#pragma unroll
                    for (int j = 0; j < 9; ++j) S.segp[j] = segp[j];
                    EpiSwiGlu E{(bf16*)(F.ws + WS_ACTS), DFE, 0, 0};
                    pg8::gemm_phase<EpiSwiGlu, pg8::MoeOrder, true>(F.lds, g, S, E, (const int*)(F.ws + WS_ROUTE + 1024 * 1024));
                }
                SEAM(pb + 10);
                if (IN(pb + 11) && PHEN(13)) REPLOOP(13) { REPBAR();
                    pg8::Gemm g{(const bf16*)(F.ws + WS_ACTS), (const bf16*)(F.ws + WS_W2), DFE, DFE, DFE};
                    const int Pm = (P >> 6) << 6, xl = P - Pm;
                    const bool spl = MK_SPLIT_M2 && xl > 0 && xl <= 32 && F.G == 256;
                    pg8::MoeOrder S; S.nM = spl ? Pm : P; S.nN = 4; S.nwg = S.nM * 4; S.G = F.G; S.c = (int)blockIdx.x; S.p0 = 0; S.sA = (size_t)256 * DFE * 2; S.sB = (size_t)256 * DFE * 2; S.a_local = 0;
                    if (spl) { S.xpm0 = Pm; S.xnp = xl; S.ntk = 56; }
                    S.wgm = MK_WGM_M2;
#pragma unroll
                    for (int j = 0; j < 9; ++j) S.segp[j] = segp[j];
                    EpiPlain E{(bf16*)(F.ws + WS_YS), 1024, (bf16*)(F.ws + WS_SLAB), Pm};
                    pg8::gemm_phase(F.lds, g, S, E);
                }
                if (IN(pb + 11) && IN(pb + NPL)) SEAM_BODY();
            }
        }
        cv_prev_done = (cv_target < DEPTH) ? (cv_next < conv_ntiles(cv_target) ? cv_next : conv_ntiles(cv_target)) : 0;
    }
    if (IN(NPHASE - 1) && PHEN(21)) { norm_phase<2>(F, DEPTH, MLAT, false, true, false, nullptr, 1); }
#undef IN
#undef SEAM
}

extern "C" void kernel_launch(void* const* d_in, const int* in_sizes, int n_in, void* d_out, int out_size, void* d_ws, size_t ws_size, hipStream_t stream) {
    static int grid = 0;
    if (grid == 0) {
        if (n_in != 29 || out_size != MLAT * D || ws_size < WS_END) { fprintf(stderr, "kernel_launch: unexpected shapes (n_in %d out %d ws %zu)\n", n_in, out_size, ws_size); grid = -1; return; }
        int dev = 0, cus = 0, per_cu = 0;
        if (hipGetDevice(&dev) != hipSuccess || hipDeviceGetAttribute(&cus, hipDeviceAttributeMultiprocessorCount, dev) != hipSuccess) { grid = -1; return; }
        if (hipFuncSetAttribute((const void*)mk_fwd, hipFuncAttributeMaxDynamicSharedMemorySize, LDS_BYTES) != hipSuccess) { fprintf(stderr, "kernel_launch: hipFuncSetAttribute failed\n"); grid = -1; return; }
        if (hipOccupancyMaxActiveBlocksPerMultiprocessor(&per_cu, (const void*)mk_fwd, 512, LDS_BYTES) != hipSuccess || per_cu < 1) fprintf(stderr, "kernel_launch: occupancy query says %d\n", per_cu);
        (void)hipGetLastError();
        grid = cus;
        if (grid != 256) { fprintf(stderr, "kernel_launch: %d CUs, expected 256\n", cus); grid = 256; }
    }
    if (grid < 0) return;
    (void)hipMemsetAsync((char*)d_ws + WS_CTL, 0, CTL_ZERO_BYTES, stream);
    Args a{};
    for (int i = 0; i < 29; ++i) a.in[i] = (const float*)d_in[i];
    a.out = (float*)d_out; a.ws = (unsigned char*)d_ws;
#if MK_ONE_LAUNCH
    a.ph_lo = 0; a.ph_hi = NPHASE;
    hipLaunchKernelGGL(mk_fwd, dim3(grid), dim3(512), LDS_BYTES, stream, a);
#else
    for (int ph = 0; ph < NPHASE; ++ph) {
        if (ph >= 1 && ph < NPHASE - 1) { const int l = (ph - 1) / NPL, j = (ph - 1) % NPL; if (!(l & 1) && j >= 11) continue; }
        a.ph_lo = ph; a.ph_hi = ph + 1;
        hipLaunchKernelGGL(mk_fwd, dim3(grid), dim3(512), LDS_BYTES, stream, a);
    }
#endif
}
```
